# Optimizing an MI355X kernel written in HIP

```python
import jax, jax.numpy as jnp
from jax import lax
import numpy as np

D_MODEL = 2048
BATCH = 1
SEQ = 8192
DEPTH = 2

GRID_W = 64
CTX_LEN = 256
N_MOD = 6
EPS = 1e-6
D_CONV = D_MODEL // 2
CONV_WIDTH = 31
D_POOL = D_MODEL // 2
POOL_WINDOWS = (2, 4, 8, 16)
N_POOL_GROUPS = len(POOL_WINDOWS)
POOL_GROUP = D_POOL // N_POOL_GROUPS
D_IN0 = 2 * D_CONV + D_POOL
HEAD_DIM = 128
N_HEADS = D_MODEL // HEAD_DIM
N_KV_HEADS = 4
GROUP = N_HEADS // N_KV_HEADS
D_Q = N_HEADS * HEAD_DIM
D_KV = N_KV_HEADS * HEAD_DIM
Q_BLOCK = 128
ROPE_AXIS = HEAD_DIM // 2
ROPE_THETA = 10000.0
ATTN_SCALE = HEAD_DIM ** -0.5
D_FF = 4 * D_MODEL

kernel_name = "hybrid_conv_pool_gqa_diffusion_block"


def _rmsnorm(x, g=None):
    xf = x.astype(jnp.float32)
    y = (xf * lax.rsqrt(jnp.mean(xf * xf, axis=-1, keepdims=True) + EPS)).astype(x.dtype)
    return y if g is None else y * g


def _layernorm(x, g, b):
    xf = x.astype(jnp.float32)
    mu = jnp.mean(xf, axis=-1, keepdims=True)
    var = jnp.mean(jnp.square(xf - mu), axis=-1, keepdims=True)
    return ((xf - mu) * lax.rsqrt(var + EPS)).astype(x.dtype) * g + b


def _adaln(cond, w, b):
    return jnp.split(jax.nn.silu(cond) @ w + b, N_MOD, axis=-1)


def _modulate(h, shift, scale):
    return h * (1 + scale) + shift


def _conformer_conv(a, gate, conv_w, conv_b, ln_g, ln_b):
    u = a * jax.nn.sigmoid(gate)
    u = lax.conv_general_dilated(
        u, conv_w[:, None, :], window_strides=(1,),
        padding=((CONV_WIDTH // 2, CONV_WIDTH // 2),),
        dimension_numbers=("NWC", "WIO", "NWC"),
        feature_group_count=D_CONV) + conv_b
    return jax.nn.silu(_layernorm(u, ln_g, ln_b))


def _pool_mixer(u, pool_w, pool_scale):
    b, n, _ = u.shape
    uf = u.astype(jnp.float32)
    cs = jnp.concatenate([jnp.zeros((b, 1, D_POOL), jnp.float32), jnp.cumsum(uf, axis=1)], axis=1)
    t = jnp.arange(n)
    means = []
    for g, w in enumerate(POOL_WINDOWS):
        lo = jnp.maximum(t - w // 2, 0)
        hi = jnp.minimum(t - w // 2 + w, n)
        cs_g = cs[..., g * POOL_GROUP:(g + 1) * POOL_GROUP]
        cnt = (hi - lo).astype(jnp.float32)[None, :, None]
        means.append((jnp.take(cs_g, hi, axis=1) - jnp.take(cs_g, lo, axis=1)) / cnt)
    d = (jnp.concatenate(means, axis=-1) - uf).astype(u.dtype)
    d = d.reshape(b, n, N_POOL_GROUPS, POOL_GROUP)
    y = jnp.einsum("bngc,gcd->bngd", d, pool_w).reshape(b, n, D_POOL)
    return y * pool_scale


def _conv_pool_mixer(h, in_w, conv_w, conv_b, ln_g, ln_b, pool_w, pool_scale, out_w):
    a, gate, u = jnp.split(h @ in_w, [D_CONV, 2 * D_CONV], axis=-1)
    y = jnp.concatenate([_conformer_conv(a, gate, conv_w, conv_b, ln_g, ln_b),
                         _pool_mixer(u, pool_w, pool_scale)], axis=-1)
    return y @ out_w


def _rope_axis(xa, pos):
    half = ROPE_AXIS // 2
    freqs = ROPE_THETA ** (-jnp.arange(half, dtype=jnp.float32) / half)
    ang = pos[:, None] * freqs[None, :]
    cos = jnp.cos(ang)[None, :, None, :]
    sin = jnp.sin(ang)[None, :, None, :]
    x1 = xa[..., :half].astype(jnp.float32)
    x2 = xa[..., half:].astype(jnp.float32)
    return jnp.concatenate([x1 * cos - x2 * sin, x1 * sin + x2 * cos], axis=-1).astype(xa.dtype)


def _rope_2d(x, pos_row, pos_col):
    return jnp.concatenate([_rope_axis(x[..., :ROPE_AXIS], pos_row),
                            _rope_axis(x[..., ROPE_AXIS:], pos_col)], axis=-1)


def _gqa_block(qb, k, v):
    s = jnp.einsum("bkgqd,bksd->bkgqs", qb, k, preferred_element_type=jnp.float32) * ATTN_SCALE
    p = jax.nn.softmax(s, axis=-1).astype(v.dtype)
    return jnp.einsum("bkgqs,bksd->bkgqd", p, v)


def _attention_mixer(h, hc, pos_row, pos_col, qkv_w, q_norm_g, k_norm_g, out_w, with_ctx_out):
    b, n, _ = h.shape
    nc = hc.shape[1]
    q, k, v = jnp.split(h @ qkv_w, [D_Q, D_Q + D_KV], axis=-1)
    q = _rope_2d(_rmsnorm(q.reshape(b, n, N_HEADS, HEAD_DIM), q_norm_g), pos_row, pos_col)
    k = _rope_2d(_rmsnorm(k.reshape(b, n, N_KV_HEADS, HEAD_DIM), k_norm_g), pos_row, pos_col)
    v = v.reshape(b, n, N_KV_HEADS, HEAD_DIM)
    if with_ctx_out:
        qc, kc, vc = jnp.split(hc @ qkv_w, [D_Q, D_Q + D_KV], axis=-1)
    else:
        kc, vc = jnp.split(hc @ qkv_w[:, D_Q:], [D_KV], axis=-1)
    kc = _rmsnorm(kc.reshape(b, nc, N_KV_HEADS, HEAD_DIM), k_norm_g)
    vc = vc.reshape(b, nc, N_KV_HEADS, HEAD_DIM)
    k_all = jnp.concatenate([kc, k], axis=1).transpose(0, 2, 1, 3)
    v_all = jnp.concatenate([vc, v], axis=1).transpose(0, 2, 1, 3)
    nb = n // Q_BLOCK
    qb = q.reshape(b, nb, Q_BLOCK, N_KV_HEADS, GROUP, HEAD_DIM).transpose(1, 0, 3, 4, 2, 5)
    o = lax.map(lambda blk: _gqa_block(blk, k_all, v_all), qb)
    o = o.transpose(1, 0, 4, 2, 3, 5).reshape(b, n, D_Q)
    y = o @ out_w
    if with_ctx_out:
        qc = _rmsnorm(qc.reshape(b, nc, N_KV_HEADS, GROUP, HEAD_DIM), q_norm_g).transpose(0, 2, 3, 1, 4)
        oc = _gqa_block(qc, kc.transpose(0, 2, 1, 3), vc.transpose(0, 2, 1, 3))
        yc = oc.transpose(0, 3, 1, 2, 4).reshape(b, nc, D_Q) @ out_w
        return y, yc
    return y, None


def _sqrelu_mlp(h, w1, w2):
    return jnp.square(jax.nn.relu(h @ w1)) @ w2


def setup_inputs(seed: int = 0) -> dict:
    key = jax.random.key(seed)
    ks = jax.random.split(key, 32)

    def nrm(k, shape, s):
        return jax.random.normal(k, shape, jnp.float32) * s

    return {
        "x": nrm(ks[0], (BATCH, SEQ, D_MODEL), 1.0),
        "c": nrm(ks[1], (BATCH, D_MODEL), 1.0),
        "ctx": nrm(ks[2], (BATCH, CTX_LEN, D_MODEL), 1.0),
        "c_ctx": nrm(ks[3], (D_MODEL,), 1.0),
        "l0_ada_w": nrm(ks[4], (D_MODEL, N_MOD * D_MODEL), 0.5 * D_MODEL ** -0.5),
        "l0_ada_b": nrm(ks[5], (N_MOD * D_MODEL,), 0.02),
        "l0_in_w": nrm(ks[6], (D_MODEL, D_IN0), D_MODEL ** -0.5),
        "l0_conv_w": nrm(ks[7], (CONV_WIDTH, D_CONV), CONV_WIDTH ** -0.5),
        "l0_conv_b": nrm(ks[8], (D_CONV,), 0.02),
        "l0_conv_ln_g": 1.0 + nrm(ks[9], (D_CONV,), 0.05),
        "l0_conv_ln_b": nrm(ks[10], (D_CONV,), 0.02),
        "l0_pool_w": nrm(ks[11], (N_POOL_GROUPS, POOL_GROUP, POOL_GROUP), POOL_GROUP ** -0.5),
        "l0_pool_scale": 1.0 + nrm(ks[12], (D_POOL,), 0.1),
        "l0_out_w": nrm(ks[13], (D_CONV + D_POOL, D_MODEL), (D_CONV + D_POOL) ** -0.5),
        "l0_mlp_w1": nrm(ks[14], (D_MODEL, D_FF), D_MODEL ** -0.5),
        "l0_mlp_w2": nrm(ks[15], (D_FF, D_MODEL), D_FF ** -0.5),
        "l1_ada_w": nrm(ks[16], (D_MODEL, N_MOD * D_MODEL), 0.5 * D_MODEL ** -0.5),
        "l1_ada_b": nrm(ks[17], (N_MOD * D_MODEL,), 0.02),
        "l1_qkv_w": nrm(ks[18], (D_MODEL, D_Q + 2 * D_KV), D_MODEL ** -0.5),
        "l1_q_norm_g": 1.0 + nrm(ks[19], (HEAD_DIM,), 0.05),
        "l1_k_norm_g": 1.0 + nrm(ks[20], (HEAD_DIM,), 0.05),
        "l1_out_w": nrm(ks[21], (D_Q, D_MODEL), D_Q ** -0.5),
        "l1_mlp_w1": nrm(ks[22], (D_MODEL, D_FF), D_MODEL ** -0.5),
        "l1_mlp_w2": nrm(ks[23], (D_FF, D_MODEL), D_FF ** -0.5),
        "final_g": 1.0 + nrm(ks[24], (D_MODEL,), 0.05),
    }


def reference(x, c, ctx, c_ctx,
              l0_ada_w, l0_ada_b, l0_in_w, l0_conv_w, l0_conv_b, l0_conv_ln_g, l0_conv_ln_b,
              l0_pool_w, l0_pool_scale, l0_out_w, l0_mlp_w1, l0_mlp_w2,
              l1_ada_w, l1_ada_b, l1_qkv_w, l1_q_norm_g, l1_k_norm_g, l1_out_w,
              l1_mlp_w1, l1_mlp_w2, final_g):
    n = x.shape[1]
    rows = n // GRID_W
    pos_row = jnp.repeat(jnp.arange(rows), GRID_W).astype(jnp.float32)
    pos_col = jnp.tile(jnp.arange(GRID_W), rows).astype(jnp.float32)

    layers = (
        (l0_ada_w, l0_ada_b,
         (l0_in_w, l0_conv_w, l0_conv_b, l0_conv_ln_g, l0_conv_ln_b, l0_pool_w, l0_pool_scale, l0_out_w),
         l0_mlp_w1, l0_mlp_w2),
        (l1_ada_w, l1_ada_b,
         (l1_qkv_w, l1_q_norm_g, l1_k_norm_g, l1_out_w),
         l1_mlp_w1, l1_mlp_w2),
    )

    for i in range(DEPTH):
        ada_w, ada_b, mix_p, w1, w2 = layers[i]
        last = i == DEPTH - 1
        sh1, sc1, g1, sh2, sc2, g2 = [m[:, None, :] for m in _adaln(c, ada_w, ada_b)]
        csh1, csc1, cg1, csh2, csc2, cg2 = _adaln(c_ctx, ada_w, ada_b)
        h = _modulate(_rmsnorm(x), sh1, sc1)
        hc = _modulate(_rmsnorm(ctx), csh1, csc1)
        if i % 2 == 0:
            y = _conv_pool_mixer(h, *mix_p)
            yc = None if last else _conv_pool_mixer(hc, *mix_p)
        else:
            y, yc = _attention_mixer(h, hc, pos_row, pos_col, *mix_p, with_ctx_out=not last)
        x = x + g1 * y
        x = x + g2 * _sqrelu_mlp(_modulate(_rmsnorm(x), sh2, sc2), w1, w2)
        if not last:
            ctx = ctx + cg1 * yc
            ctx = ctx + cg2 * _sqrelu_mlp(_modulate(_rmsnorm(ctx), csh2, csc2), w1, w2)

    return _rmsnorm(x, final_g)
```

```cpp
#include <hip/hip_runtime.h>
#include <hip/hip_cooperative_groups.h>
#include <hip/hip_bf16.h>
#include <cstdio>
#include <cstdint>
namespace cg = cooperative_groups;

#define LAS __attribute__((address_space(3)))
typedef unsigned short bf16_t;
typedef short bf16x8 __attribute__((ext_vector_type(8)));
typedef short s16x4 __attribute__((ext_vector_type(4)));
typedef float f32x4 __attribute__((ext_vector_type(4)));
typedef float f32x2 __attribute__((ext_vector_type(2)));
typedef float f32x16 __attribute__((ext_vector_type(16)));
typedef unsigned u32x4 __attribute__((ext_vector_type(4)));
typedef unsigned u32x2 __attribute__((ext_vector_type(2)));

constexpr int DM = 2048, SEQ = 8192, CTX = 256, MT = SEQ + CTX  , DFF = 8192, DIN = 3072;
constexpr int NMODV = 6 * DM;
constexpr float EPS = 1e-6f;

constexpr size_t MiB = 1u << 20;
constexpr size_t WS_MODS = 1 * MiB;
constexpr size_t WS_WIN0 = 2 * MiB, WS_WOUT0 = 14 * MiB, WS_WUP0 = 22 * MiB, WS_WDN0 = 54 * MiB;
constexpr size_t WS_WQKV1 = 86 * MiB, WS_WOUT1 = 98 * MiB, WS_WUP1 = 106 * MiB, WS_WDN1 = 138 * MiB, WS_WPOOL = 170 * MiB;
constexpr size_t WS_XR = 172 * MiB;
constexpr size_t WS_XN = 238 * MiB;
constexpr size_t WS_R = 272 * MiB;
constexpr size_t WS_GLU = WS_R, WS_U = WS_R + 33 * MiB, WS_YC = WS_R + 66 * MiB, WS_D = WS_R + 99 * MiB;
constexpr size_t WS_Q = WS_R, WS_K = WS_R + 32 * MiB, WS_V = WS_R + 41 * MiB, WS_O = WS_R + 50 * MiB;
constexpr size_t WS_QKVRAW = 404 * MiB;
constexpr size_t WS_END = 504 * MiB;

constexpr int LDS_BYTES = 147456;

__device__ __forceinline__ unsigned cvt_pk_bf16(float lo, float hi) { unsigned r; asm volatile("v_cvt_pk_bf16_f32 %0, %1, %2" : "=v"(r) : "v"(lo), "v"(hi)); return r; }
__device__ __forceinline__ float wave_sum(float v) {
#pragma unroll
    for (int o = 1; o < 64; o <<= 1) v += __shfl_xor(v, o);
    return v;
}
__device__ __forceinline__ float sigmoidf_(float g) { return 1.0f / (1.0f + __expf(-g)); }

namespace pg8 {
constexpr int BM = 256, BK = 64, HALF = 128, HTB = HALF * BK * 2, STAGE_BYTES = 8 * HTB, NXCD = 8, WGM = 8;
__host__ __device__ __forceinline__ int lds_byte(int r, int c) { const int st = (r >> 4) * 2 + (c >> 5), rr = r & 15, cc = c & 31, ob = rr * 64 + cc * 2; return st * 1024 + (ob ^ (((ob >> 9) & 1) << 5)); }
__host__ __device__ __forceinline__ void stage_rc(int b, int& R, int& C) { const int st = b / 1024, sb = b % 1024, swz = sb ^ (((sb >> 9) & 1) << 5); R = (st >> 1) * 16 + swz / 64; C = (st & 1) * 32 + (swz % 64) / 2; }
__host__ __device__ __forceinline__ int perm32(int rho) { const int n = rho >> 4, i = rho & 15; return 8 * (i >> 2) + 4 * n + (i & 3); }

struct Unit { int pm, pn; };
struct Gemm { const bf16_t* A; const bf16_t* Bt; int M, N, K, lda, ldb, a_pn_off; };

struct StaticOrder {
    int nM, nN, nwg, G, c;
    __host__ __device__ void init(int M, int N, int G_, int c_) { nM = M / BM; nN = N / BM; nwg = nM * nN; G = G_; c = c_; }
    __host__ __device__ bool next(int i, Unit& u) const {
        const long L = (long)i * G + c; if (L >= nwg) return false;
        int wgid = (int)L; { const int q = nwg / NXCD, r = nwg % NXCD, xcd = wgid % NXCD, off = wgid / NXCD; wgid = (xcd < r ? xcd * (q + 1) : r * (q + 1) + (xcd - r) * q) + off; }
        const int nig = WGM * nN, gid = wgid / nig, fm = gid * WGM, gsz = (nM - fm) < WGM ? (nM - fm) : WGM;
        u.pm = fm + ((wgid % nig) % gsz); u.pn = (wgid % nig) / gsz; return true;
    }
};

typedef f32x4 Acc[2][2][4][2];

template <int ACT, bool HAS_SCALE> struct EpiBf16 {
    static constexpr bool PERM = true;
    bf16_t* O; int ldc; int col_off; const float* scale;
    __device__ __forceinline__ void operator()(const Acc& acc, const Unit& u, int wr, int wc, int fr, int fq) const {
        const int row0 = u.pm * BM + wr * 64 + fr; const int col0 = u.pn * BM + wc * 32 + 8 * fq;
        f32x4 sv[2][2];
        if constexpr (HAS_SCALE) {
#pragma unroll
        for (int bj = 0; bj < 2; ++bj)
#pragma unroll
            for (int n = 0; n < 2; ++n) sv[bj][n] = *(const f32x4*)(scale + col0 + bj * HALF + 4 * n);
        }
#pragma unroll
        for (int ai = 0; ai < 2; ++ai)
#pragma unroll
            for (int m = 0; m < 4; ++m) { bf16_t* rowp = O + (size_t)(row0 + ai * HALF + m * 16) * ldc + col_off + col0;
#pragma unroll
                for (int bj = 0; bj < 2; ++bj) { f32x4 v0 = acc[ai][bj][m][0], v1 = acc[ai][bj][m][1];
                    if (ACT == 1) { v0 = __builtin_elementwise_max(v0, (f32x4){0.f, 0.f, 0.f, 0.f}); v1 = __builtin_elementwise_max(v1, (f32x4){0.f, 0.f, 0.f, 0.f}); v0 = v0 * v0; v1 = v1 * v1; }
                    if constexpr (HAS_SCALE) { v0 = v0 * sv[bj][0]; v1 = v1 * sv[bj][1]; }
                    u32x4 w; w.x = cvt_pk_bf16(v0[0], v0[1]); w.y = cvt_pk_bf16(v0[2], v0[3]); w.z = cvt_pk_bf16(v1[0], v1[1]); w.w = cvt_pk_bf16(v1[2], v1[3]);
                    *(u32x4*)(rowp + bj * HALF) = w; } }
    }
};
struct EpiF32 {
    static constexpr bool PERM = false;
    float* O; int ldc;
    __device__ __forceinline__ void operator()(const Acc& acc, const Unit& u, int wr, int wc, int fr, int fq) const {
        const int row0 = u.pm * BM + wr * 64 + fr; const int col0 = u.pn * BM + wc * 32 + 4 * fq;
#pragma unroll
        for (int ai = 0; ai < 2; ++ai)
#pragma unroll
            for (int m = 0; m < 4; ++m) { float* rowp = O + (size_t)(row0 + ai * HALF + m * 16) * ldc + col0;
#pragma unroll
                for (int bj = 0; bj < 2; ++bj)
#pragma unroll
                    for (int n = 0; n < 2; ++n) *(f32x4*)(rowp + bj * HALF + n * 16) = acc[ai][bj][m][n]; }
    }
};
struct EpiGlu {
    static constexpr bool PERM = false;
    float* GLU; float* U;
    __device__ __forceinline__ void operator()(const Acc& acc, const Unit& u, int wr, int wc, int fr, int fq) const {
        const int row0 = u.pm * BM + wr * 64 + fr;
        if (u.pn < 8) {
            const int col0 = u.pn * 128 + wc * 32 + 4 * fq;
#pragma unroll
            for (int ai = 0; ai < 2; ++ai)
#pragma unroll
                for (int m = 0; m < 4; ++m) { float* rowp = GLU + (size_t)(row0 + ai * HALF + m * 16) * 1024 + col0;
#pragma unroll
                    for (int n = 0; n < 2; ++n) { const f32x4 a = acc[ai][0][m][n], g = acc[ai][1][m][n]; f32x4 o;
                        o[0] = a[0] * sigmoidf_(g[0]); o[1] = a[1] * sigmoidf_(g[1]); o[2] = a[2] * sigmoidf_(g[2]); o[3] = a[3] * sigmoidf_(g[3]);
                        *(f32x4*)(rowp + n * 16) = o; } }
        } else {
            const int col0 = (u.pn - 8) * BM + wc * 32 + 4 * fq;
#pragma unroll
            for (int ai = 0; ai < 2; ++ai)
#pragma unroll
                for (int m = 0; m < 4; ++m) { float* rowp = U + (size_t)(row0 + ai * HALF + m * 16) * 1024 + col0;
#pragma unroll
                    for (int bj = 0; bj < 2; ++bj)
#pragma unroll
                        for (int n = 0; n < 2; ++n) *(f32x4*)(rowp + bj * HALF + n * 16) = acc[ai][bj][m][n]; }
        }
    }
};
struct EpiRes {
    static constexpr bool PERM = false;
    const float* baseL; const float* baseC; const float* gateL; const float* gateC; float* out;
    __device__ __forceinline__ void operator()(const Acc& acc, const Unit& u, int wr, int wc, int fr, int fq) const {
        const bool isc = u.pm >= 32;
        const int row0 = u.pm * BM + wr * 64 + fr; const int col0 = u.pn * BM + wc * 32 + 4 * fq;
        const float* gate = isc ? gateC : gateL;
        const float* base = isc ? baseC + (size_t)(row0 - SEQ) * DM : baseL + (size_t)row0 * DM;
        f32x4 gv[2][2];
#pragma unroll
        for (int bj = 0; bj < 2; ++bj)
#pragma unroll
            for (int n = 0; n < 2; ++n) gv[bj][n] = *(const f32x4*)(gate + col0 + bj * HALF + n * 16);
#pragma unroll
        for (int ai = 0; ai < 2; ++ai)
#pragma unroll
            for (int m = 0; m < 4; ++m) { const size_t ro = (size_t)(ai * HALF + m * 16) * DM + col0; float* op = out + (size_t)row0 * DM + ro;
#pragma unroll
                for (int bj = 0; bj < 2; ++bj)
#pragma unroll
                    for (int n = 0; n < 2; ++n) { const f32x4 b = *(const f32x4*)(base + ro + bj * HALF + n * 16);
                        *(f32x4*)(op + bj * HALF + n * 16) = b + gv[bj][n] * acc[ai][bj][m][n]; } }
    }
};

template <class Epi, bool ALIGN_EPI, bool SP2>
__device__ __forceinline__ void gemm_phase(LAS unsigned char* lds, const Gemm g, const StaticOrder& S, const Epi& E, const int tid) {
    const int wid = __builtin_amdgcn_readfirstlane(tid >> 6), lane = tid & 63, wr = wid >> 2, wc = wid & 3, fr = lane & 15, fq = lane >> 4;
    const int K = g.K, nt = K / BK;
    unsigned voffA[2], voffB[2];
#pragma unroll
    for (int i = 0; i < 2; ++i) { int R, C; stage_rc(tid * 16 + i * 8192, R, C); const int Rb = Epi::PERM ? ((R & ~31) + perm32(R & 31)) : R;
        voffA[i] = (unsigned)(R * g.lda + C) * 2u; voffB[i] = (unsigned)(Rb * g.ldb + C) * 2u; }
    const size_t kstep = (size_t)(BK * 2);
    const size_t hstepA = (size_t)HALF * g.lda * 2, hstepB = (size_t)HALF * g.ldb * 2;
    const unsigned ldsw = (unsigned)wid * 1024u;
    const int aoff = lds_byte(wr * 64 + fr, fq * 8), boff = lds_byte(wc * 32 + fr, fq * 8);
#define PG8_UA(u_) ((const char*)g.A + ((size_t)(u_).pm * BM * g.lda + (size_t)(u_).pn * g.a_pn_off) * 2)
#define PG8_UB(u_) ((const char*)g.Bt + (size_t)(u_).pn * BM * g.ldb * 2)
#define PG8_SA(b, h) (((b) * 2 + (h)) * HTB)
#define PG8_SB(b, h) ((4 + (b) * 2 + (h)) * HTB)
#define PG8_STAGE(bufoff, gbase, voff) do { _Pragma("unroll") for (int _i = 0; _i < 2; ++_i) \
        __builtin_amdgcn_global_load_lds((const unsigned*)((const char*)(gbase) + (voff)[_i]), (LAS unsigned*)(lds + (bufoff) + ldsw + _i * 8192), 16, 0, 0); } while (0)
#define PG8_LDA(dst, b, h) do { _Pragma("unroll") for (int m = 0; m < 4; ++m) _Pragma("unroll") for (int k = 0; k < 2; ++k) dst[m][k] = *(const LAS bf16x8*)(lds + PG8_SA(b, h) + aoff + m * 2048 + k * 1024); } while (0)
#define PG8_LDB(dst, b, h) do { _Pragma("unroll") for (int n = 0; n < 2; ++n) _Pragma("unroll") for (int k = 0; k < 2; ++k) dst[n][k] = *(const LAS bf16x8*)(lds + PG8_SB(b, h) + boff + n * 2048 + k * 1024); } while (0)
#define PG8_MMA(ai, bj, At, Bt) do { __builtin_amdgcn_s_setprio(1); _Pragma("unroll") for (int m = 0; m < 4; ++m) _Pragma("unroll") for (int n = 0; n < 2; ++n) _Pragma("unroll") for (int k = 0; k < 2; ++k) \
        acc[ai][bj][m][n] = __builtin_amdgcn_mfma_f32_16x16x32_bf16(Bt[n][k], At[m][k], acc[ai][bj][m][n], 0, 0, 0); __builtin_amdgcn_s_setprio(0); } while (0)
#define PG8_WAIT_V(n) asm volatile("s_waitcnt vmcnt(" #n ")" ::: "memory")
#define PG8_WAIT_L(n) asm volatile("s_waitcnt lgkmcnt(" #n ")" ::: "memory")
#define PG8_BAR __builtin_amdgcn_s_barrier()
#define PG8_SCHED __builtin_amdgcn_sched_barrier(0)
    Unit cur, nxt; int ui = 0;
    if (!S.next(0, cur)) return;
    f32x4 acc[2][2][4][2];
#pragma unroll
    for (int a = 0; a < 2; ++a)
#pragma unroll
        for (int b = 0; b < 2; ++b)
#pragma unroll
            for (int m = 0; m < 4; ++m)
#pragma unroll
                for (int n = 0; n < 2; ++n) acc[a][b][m][n] = (f32x4){0.f, 0.f, 0.f, 0.f};
    bf16x8 At[4][2], B0[2][2], B1[2][2];
    const char* cA = PG8_UA(cur); const char* cB = PG8_UB(cur);
    if constexpr (SP2) {
        PG8_STAGE(PG8_SB(0, 0), cB, voffB); PG8_STAGE(PG8_SB(0, 1), cB + hstepB, voffB); PG8_STAGE(PG8_SA(0, 0), cA, voffA); PG8_STAGE(PG8_SA(0, 1), cA + hstepA, voffA);
        if (wr == 1) PG8_BAR;
        PG8_WAIT_V(2); PG8_BAR;
        PG8_STAGE(PG8_SB(1, 0), cB + kstep, voffB); PG8_STAGE(PG8_SA(1, 0), cA + kstep, voffA); PG8_STAGE(PG8_SB(1, 1), cB + hstepB + kstep, voffB);
        PG8_WAIT_V(6); PG8_BAR;
    } else {
        PG8_STAGE(PG8_SB(0, 0), cB, voffB); PG8_STAGE(PG8_SA(0, 0), cA, voffA); PG8_STAGE(PG8_SB(0, 1), cB + hstepB, voffB); PG8_STAGE(PG8_SA(0, 1), cA + hstepA, voffA);
        if (wr == 1) PG8_BAR;
        PG8_WAIT_V(4); PG8_BAR;
        PG8_STAGE(PG8_SB(1, 0), cB + kstep, voffB); PG8_STAGE(PG8_SA(1, 0), cA + kstep, voffA); PG8_STAGE(PG8_SB(1, 1), cB + hstepB + kstep, voffB);
        PG8_WAIT_V(6); PG8_BAR;
    }
    for (;;) {
        const bool has_next = S.next(ui + 1, nxt);
        const char* nA = has_next ? PG8_UA(nxt) : cA; const char* nB = has_next ? PG8_UB(nxt) : cB;
        for (int t = 0; t < nt; t += 2) {
            const bool last = (t == nt - 2);
            const char* a1 = cA + (size_t)(t + 1) * kstep;
            const char* a2 = last ? nA : cA + (size_t)(t + 2) * kstep; const char* b2 = last ? nB : cB + (size_t)(t + 2) * kstep;
            const char* a3 = a2 + kstep; const char* b3 = b2 + kstep;
            if constexpr (SP2) {
            PG8_LDB(B0, 0, 0); PG8_LDB(B1, 0, 1); PG8_SCHED; PG8_LDA(At, 0, 0); PG8_STAGE(PG8_SA(1, 1), a1 + hstepA, voffA);
            PG8_WAIT_V(8); PG8_WAIT_L(0); PG8_BAR; PG8_MMA(0, 0, At, B0); PG8_MMA(0, 1, At, B1); PG8_BAR; PG8_SCHED;
            PG8_LDA(At, 0, 1); PG8_STAGE(PG8_SB(0, 0), b2, voffB); PG8_STAGE(PG8_SB(0, 1), b2 + hstepB, voffB); PG8_STAGE(PG8_SA(0, 0), a2, voffA);
            PG8_WAIT_V(8); PG8_WAIT_L(0); PG8_BAR; PG8_MMA(1, 0, At, B0); PG8_MMA(1, 1, At, B1); PG8_BAR; PG8_SCHED;
            PG8_LDB(B0, 1, 0); PG8_LDB(B1, 1, 1); PG8_SCHED; PG8_LDA(At, 1, 0); PG8_STAGE(PG8_SA(0, 1), a2 + hstepA, voffA);
            PG8_WAIT_V(8); PG8_WAIT_L(0); PG8_BAR; PG8_MMA(0, 0, At, B0); PG8_MMA(0, 1, At, B1); PG8_BAR; PG8_SCHED;
            PG8_LDA(At, 1, 1); PG8_STAGE(PG8_SB(1, 0), b3, voffB); PG8_STAGE(PG8_SB(1, 1), b3 + hstepB, voffB); PG8_STAGE(PG8_SA(1, 0), a3, voffA);
            PG8_WAIT_V(8); PG8_WAIT_L(0); PG8_BAR; PG8_MMA(1, 0, At, B0); PG8_MMA(1, 1, At, B1); PG8_BAR; PG8_SCHED;
            } else {
            PG8_LDB(B0, 0, 0); PG8_SCHED; PG8_LDA(At, 0, 0); PG8_STAGE(PG8_SA(1, 1), a1 + hstepA, voffA);
            PG8_WAIT_L(8); PG8_BAR; PG8_WAIT_L(0); PG8_MMA(0, 0, At, B0); PG8_BAR; PG8_SCHED;
            PG8_LDB(B1, 0, 1); PG8_STAGE(PG8_SB(0, 0), b2, voffB);
            PG8_BAR; PG8_WAIT_L(0); PG8_MMA(0, 1, At, B1); PG8_BAR;
            PG8_LDA(At, 0, 1); PG8_STAGE(PG8_SA(0, 0), a2, voffA);
            PG8_BAR; PG8_WAIT_L(0); PG8_MMA(1, 0, At, B0); PG8_BAR; PG8_SCHED;
            PG8_STAGE(PG8_SB(0, 1), b2 + hstepB, voffB);
            PG8_WAIT_V(6); PG8_BAR; PG8_MMA(1, 1, At, B1); PG8_BAR;
            PG8_LDB(B0, 1, 0); PG8_SCHED; PG8_LDA(At, 1, 0); PG8_STAGE(PG8_SA(0, 1), a2 + hstepA, voffA);
            PG8_WAIT_L(8); PG8_BAR; PG8_WAIT_L(0); PG8_MMA(0, 0, At, B0); PG8_BAR; PG8_SCHED;
            PG8_LDB(B1, 1, 1); PG8_STAGE(PG8_SB(1, 0), b3, voffB);
            PG8_BAR; PG8_WAIT_L(0); PG8_MMA(0, 1, At, B1); PG8_BAR;
            PG8_LDA(At, 1, 1); PG8_STAGE(PG8_SA(1, 0), a3, voffA);
            PG8_BAR; PG8_WAIT_L(0); PG8_MMA(1, 0, At, B0); PG8_BAR; PG8_SCHED;
            PG8_STAGE(PG8_SB(1, 1), b3 + hstepB, voffB);
            PG8_WAIT_V(6); PG8_BAR; PG8_MMA(1, 1, At, B1); PG8_BAR;
            }
        }
        if constexpr (ALIGN_EPI) { if (wr == 0) PG8_BAR; }
        E(acc, cur, wr, wc, fr, fq);
        if (!has_next) break;
#pragma unroll
        for (int a = 0; a < 2; ++a)
#pragma unroll
            for (int b = 0; b < 2; ++b)
#pragma unroll
                for (int m = 0; m < 4; ++m)
#pragma unroll
                    for (int n = 0; n < 2; ++n) acc[a][b][m][n] = (f32x4){0.f, 0.f, 0.f, 0.f};
        cur = nxt; cA = nA; cB = nB; ++ui;
        if constexpr (ALIGN_EPI) { if (wr == 1) PG8_BAR; }
    }
    PG8_WAIT_V(0);
    if constexpr (!ALIGN_EPI) { if (wr == 0) PG8_BAR; }
    PG8_BAR;
#undef PG8_UA
#undef PG8_UB
#undef PG8_SA
#undef PG8_SB
#undef PG8_STAGE
#undef PG8_LDA
#undef PG8_LDB
#undef PG8_MMA
#undef PG8_WAIT_V
#undef PG8_WAIT_L
#undef PG8_BAR
#undef PG8_SCHED
}
}

namespace att {
using bf16 = __hip_bfloat16;
constexpr int D = 128, NW = 8, QBLK = 32, KVBLK = 64;
constexpr float SCALE = 0.088388347648318440f;
constexpr float THR = 8.f;
constexpr int LDQ = 2048, LDK = 512, LDO = 2048;
constexpr size_t SHM_V = KVBLK * D * 2, SHM_K = KVBLK * D * 2, SHM_ATTN = 2 * SHM_V + 2 * SHM_K + NW * 64 * 4;
#define KSWZ(row, colB) ((row) * 256 + ((colB) ^ (((row) & 7) << 4)))
#define SBAR() __builtin_amdgcn_sched_barrier(0)
__device__ __forceinline__ int crow(int r, int hi) { return (r & 3) + 8 * (r >> 2) + 4 * hi; }
__device__ __forceinline__ unsigned cvtpk(float lo, float hi) { unsigned r; asm volatile("v_cvt_pk_bf16_f32 %0, %1, %2" : "=v"(r) : "v"(lo), "v"(hi)); return r; }
__device__ __forceinline__ bf16x8 ld8(const bf16* p) { return *reinterpret_cast<const bf16x8*>(p); }

__device__ __forceinline__ void partialSM(f32x16& p0, f32x16& p1, float& m_reg, float& mn, float& alpha) {
  constexpr float C = SCALE * 1.4426950408889634f;
  float pmax = p0[0]; for (int r = 1; r < 16; ++r) pmax = fmaxf(pmax, p0[r]); for (int r = 0; r < 16; ++r) pmax = fmaxf(pmax, p1[r]);
  { auto rr = __builtin_amdgcn_permlane32_swap(__float_as_uint(pmax), __float_as_uint(pmax), false, false);
    pmax = fmaxf(__uint_as_float(rr[0]), __uint_as_float(rr[1])); }
  if (__builtin_expect(__all(pmax - m_reg <= THR / SCALE), 1)) { mn = m_reg; alpha = 1.f; }
  else { mn = fmaxf(m_reg, pmax); alpha = __builtin_amdgcn_exp2f((m_reg - mn) * C); m_reg = mn; }
  float mnC = -mn * C;
  for (int r = 0; r < 16; ++r) p0[r] = fmaf(p0[r], C, mnC); for (int r = 0; r < 16; ++r) p1[r] = fmaf(p1[r], C, mnC);
  for (int r = 0; r < 16; ++r) p0[r] = __builtin_amdgcn_exp2f(p0[r]);
}
__device__ __forceinline__ void finishSM(f32x16& p0, f32x16& p1, float alpha, float& l_reg, bf16x8& pa0, bf16x8& pa1, bf16x8& pa2, bf16x8& pa3) {
  for (int r = 0; r < 16; ++r) p1[r] = __builtin_amdgcn_exp2f(p1[r]);
  float ps = 0; for (int r = 0; r < 16; ++r) ps += p0[r]; for (int r = 0; r < 16; ++r) ps += p1[r];
  { auto rr = __builtin_amdgcn_permlane32_swap(__float_as_uint(ps), __float_as_uint(ps), false, false);
    ps = __uint_as_float(rr[0]) + __uint_as_float(rr[1]); }
  l_reg = l_reg * alpha + ps;
#define PK4(P, BASE, OUT) do { unsigned a0 = cvtpk(P[BASE + 0], P[BASE + 1]), a1 = cvtpk(P[BASE + 2], P[BASE + 3]);   \
    unsigned b0 = cvtpk(P[BASE + 4], P[BASE + 5]), b1 = cvtpk(P[BASE + 6], P[BASE + 7]);                              \
    auto r0 = __builtin_amdgcn_permlane32_swap(a0, b0, false, false); auto r1 = __builtin_amdgcn_permlane32_swap(a1, b1, false, false); \
    u32x4 w = {r0[0], r1[0], r0[1], r1[1]}; OUT = *reinterpret_cast<bf16x8*>(&w); } while (0)
  PK4(p0, 0, pa0); PK4(p0, 8, pa1); PK4(p1, 0, pa2); PK4(p1, 8, pa3);
#undef PK4
}
__device__ __forceinline__ void qkt(f32x16& p0, f32x16& p1, const bf16* Ks, const bf16x8* qr, int r32, int hi) {
  p0 = f32x16{}; p1 = f32x16{};
  for (int d0 = 0; d0 < 8; ++d0) { int cb = (d0 * 16 + hi * 8) * 2;
    bf16x8 b0 = *reinterpret_cast<const bf16x8*>((const char*)Ks + KSWZ(r32, cb));
    bf16x8 b1 = *reinterpret_cast<const bf16x8*>((const char*)Ks + KSWZ(32 + r32, cb));
    p0 = __builtin_amdgcn_mfma_f32_32x32x16_bf16(b0, qr[d0], p0, 0, 0, 0);
    p1 = __builtin_amdgcn_mfma_f32_32x32x16_bf16(b1, qr[d0], p1, 0, 0, 0); }
}
__device__ __forceinline__ int v_st(int k, int c) { const int kk = (k & ~0xC) | ((k & 4) << 1) | ((k & 8) >> 1); return ((kk >> 3) * 4 + (c >> 5)) * 512 + ((kk & 7) * 32 + (c & 31)) * 2; }
__device__ __forceinline__ int v_rd_base(int lane) { return ((lane & 3) << 3) | (((lane >> 2) & 3) << 6) | (((lane >> 4) & 1) << 5) | (((lane >> 5) & 1) << 8); }
constexpr int v_rd_off(int d0, int ks, int half) { return d0 * 512 + ks * 4096 + half * 2048; }
template <int OFF> __device__ __forceinline__ s16x4 tr_read(int vb) {
  s16x4 r; asm volatile("ds_read_b64_tr_b16 %0, %1 offset:%2" : "=&v"(r) : "v"(vb), "i"(OFF) : "memory"); return r;
}
template <int D0> __device__ __forceinline__ void pv_one(f32x16& od, int vb, bf16x8 pa0, bf16x8 pa1, bf16x8 pa2, bf16x8 pa3) {
  const s16x4 l0 = tr_read<v_rd_off(D0, 0, 0)>(vb), h0 = tr_read<v_rd_off(D0, 0, 1)>(vb), l1 = tr_read<v_rd_off(D0, 1, 0)>(vb), h1 = tr_read<v_rd_off(D0, 1, 1)>(vb);
  const s16x4 l2 = tr_read<v_rd_off(D0, 2, 0)>(vb), h2 = tr_read<v_rd_off(D0, 2, 1)>(vb), l3 = tr_read<v_rd_off(D0, 3, 0)>(vb), h3 = tr_read<v_rd_off(D0, 3, 1)>(vb);
  asm volatile("s_waitcnt lgkmcnt(0)" ::: "memory"); SBAR();
#define PK(L, H) (bf16x8){L[0], L[1], L[2], L[3], H[0], H[1], H[2], H[3]}
  od = __builtin_amdgcn_mfma_f32_32x32x16_bf16(pa0, PK(l0, h0), od, 0, 0, 0);
  od = __builtin_amdgcn_mfma_f32_32x32x16_bf16(pa1, PK(l1, h1), od, 0, 0, 0);
  od = __builtin_amdgcn_mfma_f32_32x32x16_bf16(pa2, PK(l2, h2), od, 0, 0, 0);
  od = __builtin_amdgcn_mfma_f32_32x32x16_bf16(pa3, PK(l3, h3), od, 0, 0, 0);
#undef PK
}
__device__ __forceinline__ void pv_d0(f32x16* o, int vb, bf16x8 pa0, bf16x8 pa1, bf16x8 pa2, bf16x8 pa3) {
  pv_one<0>(o[0], vb, pa0, pa1, pa2, pa3); pv_one<1>(o[1], vb, pa0, pa1, pa2, pa3); pv_one<2>(o[2], vb, pa0, pa1, pa2, pa3); pv_one<3>(o[3], vb, pa0, pa1, pa2, pa3);
}

__device__ __forceinline__ void attn_dense_body(const bf16* __restrict__ Qb, const bf16* __restrict__ Kh, const bf16* __restrict__ Vh,
                                                bf16* __restrict__ Ob, int seq, char* lds, const int tid) {
  const int wid = tid >> 6, lane = tid & 63, r32 = lane & 31, hi = lane >> 5;
  bf16* V_lds = (bf16*)lds; bf16* K_lds = (bf16*)(lds + 2 * SHM_V);
  float* ws = (float*)(lds + 2 * SHM_V + 2 * SHM_K) + wid * 64; float* li_l = ws; float* al_l = ws + 32;
  float m_reg = -1e30f, l_reg = 0; f32x16 o[4] = {}; bf16x8 qr[8];
  const bf16* Qw = Qb + (long)(wid * QBLK + r32) * LDQ + hi * 8;
#pragma unroll
  for (int d0 = 0; d0 < 8; ++d0) qr[d0] = ld8(Qw + d0 * 16);
  const int sr = tid >> 4, sc = (tid & 15) * 8, vst0 = v_st(sr, sc), vst1 = v_st(32 + sr, sc);
  const int vb0 = (int)(uintptr_t)V_lds + v_rd_base(lane);
  struct { bf16x8 vs0, vs1, ks0, ks1; } sr_[2];
#define SLOAD(i, k0) do { sr_[i].vs0 = ld8(&Vh[(long)((k0) + sr) * LDK + sc]); sr_[i].vs1 = ld8(&Vh[(long)((k0) + 32 + sr) * LDK + sc]); \
    sr_[i].ks0 = ld8(&Kh[(long)((k0) + sr) * LDK + sc]); sr_[i].ks1 = ld8(&Kh[(long)((k0) + 32 + sr) * LDK + sc]); } while (0)
#define SWRITE(b, i) do { *(bf16x8*)((char*)V_lds + (b) * SHM_V + vst0) = sr_[i].vs0;          \
    *(bf16x8*)((char*)V_lds + (b) * SHM_V + vst1) = sr_[i].vs1; int kc = sc * 2;               \
    *(bf16x8*)((char*)K_lds + (b) * SHM_K + KSWZ(sr, kc)) = sr_[i].ks0;                       \
    *(bf16x8*)((char*)K_lds + (b) * SHM_K + KSWZ(32 + sr, kc)) = sr_[i].ks1; } while (0)
#define SWAIT() asm volatile("s_waitcnt vmcnt(4)" ::: "memory")
#define RESC(a) do { if (__any((a) < 1.f)) { if (hi == 0) al_l[r32] = (a); asm volatile("s_waitcnt lgkmcnt(0)" ::: "memory"); \
    for (int d = 0; d < 4; ++d) for (int r = 0; r < 16; ++r) o[d][r] *= al_l[crow(r, hi)]; } } while (0)
  f32x16 pA0, pA1, pB0, pB1; float mnA, mnB, alA, alB; bf16x8 pa0, pa1, pa2, pa3; const int NT = seq / KVBLK;
  constexpr int SE = 0, SO = 1;
  SLOAD(SE, 0); asm volatile("s_waitcnt vmcnt(0)" ::: "memory"); SWRITE(0, SE); __syncthreads();
  qkt(pA0, pA1, K_lds, qr, r32, hi); partialSM(pA0, pA1, m_reg, mnA, alA);
  SLOAD(SO, KVBLK); if (2 < NT) SLOAD(SE, 2 * KVBLK);
  SWAIT(); SWRITE(1, SO); __syncthreads();
  for (int j = 1; j + 1 < NT; j += 2) {
    SBAR(); qkt(pB0, pB1, (bf16*)((char*)K_lds + SHM_K), qr, r32, hi);
    finishSM(pA0, pA1, alA, l_reg, pa0, pa1, pa2, pa3); SBAR();
    SLOAD(SO, (j + 2) * KVBLK); SBAR();
    pv_d0(o, vb0, pa0, pa1, pa2, pa3); partialSM(pB0, pB1, m_reg, mnB, alB);
    __syncthreads(); SWAIT(); SWRITE(0, SE);
    RESC(alB); __syncthreads();
    SBAR(); qkt(pA0, pA1, K_lds, qr, r32, hi);
    finishSM(pB0, pB1, alB, l_reg, pa0, pa1, pa2, pa3); SBAR();
    if (j + 3 < NT) SLOAD(SE, (j + 3) * KVBLK); SBAR();
    pv_d0(o, vb0 + (int)SHM_V, pa0, pa1, pa2, pa3); partialSM(pA0, pA1, m_reg, mnA, alA);
    __syncthreads(); SWAIT(); SWRITE(1, SO);
    RESC(alA); __syncthreads();
  }
  SBAR(); qkt(pB0, pB1, (bf16*)((char*)K_lds + SHM_K), qr, r32, hi);
  finishSM(pA0, pA1, alA, l_reg, pa0, pa1, pa2, pa3); SBAR();
  pv_d0(o, vb0, pa0, pa1, pa2, pa3); partialSM(pB0, pB1, m_reg, mnB, alB);
  __syncthreads(); RESC(alB);
  finishSM(pB0, pB1, alB, l_reg, pa0, pa1, pa2, pa3); SBAR();
  pv_d0(o, vb0 + (int)SHM_V, pa0, pa1, pa2, pa3);
  if (hi == 0) li_l[r32] = l_reg; asm volatile("s_waitcnt lgkmcnt(0)" ::: "memory");
  float rli[16];
#pragma unroll
  for (int r = 0; r < 16; ++r) rli[r] = __builtin_amdgcn_rcpf(li_l[crow(r, hi)]);
  bf16* Ow = Ob + (long)(wid * QBLK) * LDO;
#pragma unroll
  for (int r = 0; r < 16; ++r) { int orow = crow(r, hi);
    for (int d0 = 0; d0 < 4; ++d0) Ow[(long)orow * LDO + d0 * 32 + r32] = __float2bfloat16(o[d0][r] * rli[r]); }
  __syncthreads();
#undef SLOAD
#undef SWRITE
#undef SWAIT
#undef RESC
}
#undef KSWZ
#undef SBAR
}

__device__ __forceinline__ void transpose_item(const float* W, int K, int N, bf16_t* WT, int glu_perm, LAS float* scr, int item, int lane, const float* colscale = nullptr) {
    const int nblk = N / 32, kb = item / nblk, nb = item % nblk, k0 = 64 * kb, n0 = 32 * nb;
    int r0 = n0;
    if (glu_perm && n0 < 2048) { const int half = n0 >> 10, ch = n0 & 1023; r0 = (ch >> 7) * 256 + half * 128 + (ch & 127); }
    const float csc = colscale ? colscale[n0 + (lane & 31)] : 1.0f;
#pragma unroll 8
    for (int i = 0; i < 32; ++i) { const int kk = 2 * i + (lane >> 5); scr[kk * 33 + (lane & 31)] = W[(size_t)(k0 + kk) * N + n0 + (lane & 31)] * csc; }
    asm volatile("s_waitcnt lgkmcnt(0)" ::: "memory");
    const int c = lane & 7;
#pragma unroll
    for (int j = 0; j < 4; ++j) { const int n = (lane >> 3) + 8 * j; const LAS float* s = scr + (8 * c) * 33 + n;
        u32x4 o; o.x = cvt_pk_bf16(s[0 * 33], s[1 * 33]); o.y = cvt_pk_bf16(s[2 * 33], s[3 * 33]); o.z = cvt_pk_bf16(s[4 * 33], s[5 * 33]); o.w = cvt_pk_bf16(s[6 * 33], s[7 * 33]);
        *(u32x4*)(WT + (size_t)(r0 + n) * K + k0 + 8 * c) = o; }
    asm volatile("s_waitcnt lgkmcnt(0)" ::: "memory");
}

__device__ __forceinline__ void norm_mod_row(const float* xrow, const float* sh, const float* sc, bf16_t* orow, int lane) {
    const f32x4* xr = (const f32x4*)xrow + lane; f32x4 v[8]; float s = 0.f;
#pragma unroll
    for (int j = 0; j < 8; ++j) { v[j] = xr[64 * j]; s += (v[j].x * v[j].x + v[j].y * v[j].y) + (v[j].z * v[j].z + v[j].w * v[j].w); }
    const float rstd = 1.0f / sqrtf(wave_sum(s) * (1.f / DM) + EPS);
    u32x2* o8 = (u32x2*)orow + lane;
#pragma unroll
    for (int j = 0; j < 8; ++j) { const f32x4 a = ((const f32x4*)sc)[lane + 64 * j], b = ((const f32x4*)sh)[lane + 64 * j]; const f32x4 y = v[j] * rstd * (a + 1.0f) + b;
        u32x2 w; w.x = cvt_pk_bf16(y.x, y.y); w.y = cvt_pk_bf16(y.z, y.w); o8[64 * j] = w; }
}

template <int W> __device__ __forceinline__ void pool_chunk(const float* U, bf16_t* Dd, int row0, int seq_lo, int seq_hi, int ch) {
    f32x2 in[W + 7];
#pragma unroll
    for (int i = 0; i < W + 7; ++i) { const int r = row0 - W / 2 + i; const bool ok = (r >= seq_lo) && (r < seq_hi);
        in[i] = ok ? *(const f32x2*)(U + (size_t)r * 1024 + ch) : (f32x2){0.f, 0.f}; }
#pragma unroll
    for (int o = 0; o < 8; ++o) { f32x2 s = {0.f, 0.f};
#pragma unroll
        for (int j = 0; j < W; ++j) s += in[o + j];
        const int t = row0 + o; const int lo = max(t - W / 2, seq_lo), hi = min(t - W / 2 + W, seq_hi); const float inv = 1.0f / (float)(hi - lo);
        const f32x2 d = s * inv - in[o + W / 2];
        *(unsigned*)(Dd + (size_t)t * 1024 + ch) = cvt_pk_bf16(d.x, d.y); }
}

struct Params { const float* in[25]; float* out; unsigned char* ws; };

__global__ void __launch_bounds__(512, 2) fwd_mega(Params p) {
    extern __shared__ __attribute__((aligned(16))) unsigned char lds_raw[];
    cg::grid_group grid = cg::this_grid();
    LAS unsigned char* lds = (LAS unsigned char*)lds_raw;
    const int G = gridDim.x, bx = blockIdx.x;
#define PHASE_BEGIN() int tid = threadIdx.x; asm volatile("" : "+v"(tid)); size_t wz_ = 0; asm volatile("" : "+s"(wz_)); unsigned char* ws = p.ws + wz_; \
    const int lane = tid & 63, wave = __builtin_amdgcn_readfirstlane(tid >> 6); const int gw = bx * 8 + wave, NGW = G * 8; (void)lane; (void)gw; (void)NGW; \
    float* MODS = (float*)(ws + WS_MODS); (void)MODS
#define DEFP(T, name, off) T* name = (T*)(ws + (off))
#define MOD(l, cnd, chunk) (MODS + ((l) * 2 + (cnd)) * NMODV + (chunk) * DM)

    {
        PHASE_BEGIN();
        LAS float* sS = (LAS float*)lds;
        LAS float* red = (LAS float*)(lds + 16384);
        for (int k = tid; k < DM; k += 512) { const float a = p.in[1][k], b = p.in[3][k]; sS[k] = a / (1.0f + expf(-a)); sS[DM + k] = b / (1.0f + expf(-b)); }
        __syncthreads();
        const int cgi = tid & 7, ks = tid >> 3;
        for (int item = bx; item < 768; item += G) {
            const int l = item / 384, col0 = (item % 384) * 32;
            const float* Wa = l ? p.in[16] : p.in[4]; const float* bvec = l ? p.in[17] : p.in[5];
            f32x4 a0 = {0.f, 0.f, 0.f, 0.f}, a1 = {0.f, 0.f, 0.f, 0.f};
            const float* wp = Wa + (size_t)(ks * 32) * NMODV + col0 + cgi * 4;
#pragma unroll 8
            for (int kk = 0; kk < 32; ++kk) { const f32x4 w = *(const f32x4*)(wp + (size_t)kk * NMODV); const float s0 = sS[ks * 32 + kk], s1 = sS[DM + ks * 32 + kk]; a0 += w * s0; a1 += w * s1; }
            *(LAS f32x4*)(red + (ks * 8 + cgi) * 8) = a0; *(LAS f32x4*)(red + (ks * 8 + cgi) * 8 + 4) = a1;
            __syncthreads();
            if (tid < 64) { float s = 0.f;
#pragma unroll 8
                for (int q = 0; q < 64; ++q) s += red[q * 64 + tid];
                const int cnd = (tid >> 2) & 1, colj = (tid >> 3) * 4 + (tid & 3);
                MODS[(l * 2 + cnd) * NMODV + col0 + colj] = s + bvec[col0 + colj]; }
            __syncthreads();
        }
        __syncthreads();
        LAS float* scr = (LAS float*)(lds + wave * 16384);
        constexpr int I_IN = 32 * 96, I_OUT = 32 * 64, I_UP = 32 * 256, I_DN = 128 * 64, I_PW = 4 * 8;
        constexpr int NITEMS = 2 * (I_IN + I_OUT + I_UP + I_DN) + 4 * I_PW;
        for (int it = gw; it < NITEMS; it += NGW) {
            int r = it;
            if (r < I_IN) { transpose_item(p.in[6], DM, DIN, (bf16_t*)(ws + WS_WIN0), 1, scr, r, lane); continue; } r -= I_IN;
            if (r < I_OUT) { transpose_item(p.in[13], DM, DM, (bf16_t*)(ws + WS_WOUT0), 0, scr, r, lane); continue; } r -= I_OUT;
            if (r < I_UP) { transpose_item(p.in[14], DM, DFF, (bf16_t*)(ws + WS_WUP0), 0, scr, r, lane); continue; } r -= I_UP;
            if (r < I_DN) { transpose_item(p.in[15], DFF, DM, (bf16_t*)(ws + WS_WDN0), 0, scr, r, lane); continue; } r -= I_DN;
            if (r < I_IN) { transpose_item(p.in[18], DM, DIN, (bf16_t*)(ws + WS_WQKV1), 0, scr, r, lane); continue; } r -= I_IN;
            if (r < I_OUT) { transpose_item(p.in[21], DM, DM, (bf16_t*)(ws + WS_WOUT1), 0, scr, r, lane); continue; } r -= I_OUT;
            if (r < I_UP) { transpose_item(p.in[22], DM, DFF, (bf16_t*)(ws + WS_WUP1), 0, scr, r, lane); continue; } r -= I_UP;
            if (r < I_DN) { transpose_item(p.in[23], DFF, DM, (bf16_t*)(ws + WS_WDN1), 0, scr, r, lane); continue; } r -= I_DN;
            { const int gidx = r / I_PW; transpose_item(p.in[11] + (size_t)gidx * 65536, 256, 256, (bf16_t*)(ws + WS_WPOOL) + (size_t)gidx * 65536, 0, scr, r % I_PW, lane, p.in[12] + gidx * 256); }
        }
    }
    grid.sync();

    {
        PHASE_BEGIN(); DEFP(bf16_t, XN, WS_XN);
        for (int row = gw; row < MT; row += NGW) {
            const bool isc = row >= SEQ;
            norm_mod_row(isc ? p.in[2] + (size_t)(row - SEQ) * DM : p.in[0] + (size_t)row * DM, MOD(0, isc ? 1 : 0, 0), MOD(0, isc ? 1 : 0, 1), XN + (size_t)row * DM, lane);
        }
    }
    grid.sync();

    {
        PHASE_BEGIN(); DEFP(bf16_t, XN, WS_XN); DEFP(bf16_t, W_IN0, WS_WIN0); DEFP(float, GLU, WS_GLU); DEFP(float, U, WS_U);
        pg8::Gemm g{XN, W_IN0, MT, DIN, DM, DM, DM, 0}; pg8::StaticOrder S; S.init(MT, DIN, G, bx);
        pg8::EpiGlu E{GLU, U};
        pg8::gemm_phase<pg8::EpiGlu, true, true>(lds, g, S, E, tid);
    }
    grid.sync();

    {
        PHASE_BEGIN(); DEFP(float, GLU, WS_GLU); DEFP(float, U, WS_U); DEFP(bf16_t, YC, WS_YC); DEFP(bf16_t, Dd, WS_D);
        const int ch = 2 * tid;
        f32x2 cw[31];
#pragma unroll
        for (int j = 0; j < 31; ++j) cw[j] = *(const f32x2*)(p.in[7] + j * 1024 + ch);
        const f32x2 cb = *(const f32x2*)(p.in[8] + ch), lg = *(const f32x2*)(p.in[9] + ch), lb = *(const f32x2*)(p.in[10] + ch);
        LAS float* red1 = (LAS float*)lds; LAS float* red2 = (LAS float*)(lds + 256);
        for (int chunk = bx; chunk < MT / 8; chunk += G) {
            const int row0 = chunk * 8; const int seq_lo = row0 < SEQ ? 0 : SEQ, seq_hi = row0 < SEQ ? SEQ : MT;
            f32x2 acc[8];
#pragma unroll
            for (int o = 0; o < 8; ++o) acc[o] = cb;
#pragma unroll
            for (int i = 0; i < 38; ++i) { const int r = row0 - 15 + i; const bool ok = (r >= seq_lo) && (r < seq_hi);
                const f32x2 xv = ok ? *(const f32x2*)(GLU + (size_t)r * 1024 + ch) : (f32x2){0.f, 0.f};
#pragma unroll
                for (int o = 0; o < 8; ++o) { const int j = i - o; if (j >= 0 && j < 31) acc[o] += xv * cw[j]; } }
            float s[8];
#pragma unroll
            for (int o = 0; o < 8; ++o) s[o] = wave_sum(acc[o].x + acc[o].y);
            if (lane == 0) {
#pragma unroll
                for (int o = 0; o < 8; ++o) red1[wave * 8 + o] = s[o]; }
            __syncthreads();
#pragma unroll
            for (int o = 0; o < 8; ++o) { float t = 0.f;
#pragma unroll
                for (int w = 0; w < 8; ++w) t += red1[w * 8 + o];
                const float mean = t * (1.f / 1024.f); acc[o] = acc[o] - mean; s[o] = wave_sum(acc[o].x * acc[o].x + acc[o].y * acc[o].y); }
            if (lane == 0) {
#pragma unroll
                for (int o = 0; o < 8; ++o) red2[wave * 8 + o] = s[o]; }
            __syncthreads();
#pragma unroll
            for (int o = 0; o < 8; ++o) { float t = 0.f;
#pragma unroll
                for (int w = 0; w < 8; ++w) t += red2[w * 8 + o];
                const float rstd = 1.0f / sqrtf(t * (1.f / 1024.f) + EPS);
                const f32x2 y = acc[o] * rstd * lg + lb;
                const float y0 = y.x * sigmoidf_(y.x), y1 = y.y * sigmoidf_(y.y);
                *(unsigned*)(YC + (size_t)(row0 + o) * DM + ch) = cvt_pk_bf16(y0, y1); }
            const int pg = wave >> 1;
            if (pg == 0) pool_chunk<2>(U, Dd, row0, seq_lo, seq_hi, ch);
            else if (pg == 1) pool_chunk<4>(U, Dd, row0, seq_lo, seq_hi, ch);
            else if (pg == 2) pool_chunk<8>(U, Dd, row0, seq_lo, seq_hi, ch);
            else pool_chunk<16>(U, Dd, row0, seq_lo, seq_hi, ch);
        }
    }
    grid.sync();

    {
        PHASE_BEGIN(); DEFP(bf16_t, Dd, WS_D); DEFP(bf16_t, W_POOL, WS_WPOOL); DEFP(bf16_t, YC, WS_YC);
        pg8::Gemm g{Dd, W_POOL, MT, 1024, 256, 1024, 256, 256}; pg8::StaticOrder S; S.init(MT, 1024, G, bx);
        pg8::EpiBf16<0, false> E{YC, DM, 1024, nullptr};
        pg8::gemm_phase<pg8::EpiBf16<0, false>, true, true>(lds, g, S, E, tid);
    }
    grid.sync();

    {
        PHASE_BEGIN(); DEFP(bf16_t, YC, WS_YC); DEFP(bf16_t, W_OUT0, WS_WOUT0); DEFP(float, XR, WS_XR);
        pg8::Gemm g{YC, W_OUT0, MT, DM, DM, DM, DM, 0}; pg8::StaticOrder S; S.init(MT, DM, G, bx);
        pg8::EpiRes E{p.in[0], p.in[2], MOD(0, 0, 2), MOD(0, 1, 2), XR};
        pg8::gemm_phase<pg8::EpiRes, true, true>(lds, g, S, E, tid);
    }
    grid.sync();

    {
        PHASE_BEGIN(); DEFP(bf16_t, XN, WS_XN); DEFP(float, XR, WS_XR);
        for (int row = gw; row < MT; row += NGW) {
            const int cnd = row >= SEQ ? 1 : 0;
            norm_mod_row(XR + (size_t)row * DM, MOD(0, cnd, 3), MOD(0, cnd, 4), XN + (size_t)row * DM, lane);
        }
    }
    grid.sync();

    {
        PHASE_BEGIN(); DEFP(bf16_t, XN, WS_XN); DEFP(bf16_t, W_UP0, WS_WUP0); DEFP(bf16_t, H, WS_R);
        pg8::Gemm g{XN, W_UP0, MT, DFF, DM, DM, DM, 0}; pg8::StaticOrder S; S.init(MT, DFF, G, bx);
        pg8::EpiBf16<1, false> E{H, DFF, 0, nullptr};
        pg8::gemm_phase<pg8::EpiBf16<1, false>, true, true>(lds, g, S, E, tid);
    }
    grid.sync();

    {
        PHASE_BEGIN(); DEFP(bf16_t, H, WS_R); DEFP(bf16_t, W_DN0, WS_WDN0); DEFP(float, XR, WS_XR);
        pg8::Gemm g{H, W_DN0, MT, DM, DFF, DFF, DFF, 0}; pg8::StaticOrder S; S.init(MT, DM, G, bx);
        pg8::EpiRes E{XR, XR + (size_t)SEQ * DM, MOD(0, 0, 5), MOD(0, 1, 5), XR};
        pg8::gemm_phase<pg8::EpiRes, true, true>(lds, g, S, E, tid);
    }
    grid.sync();

    {
        PHASE_BEGIN(); DEFP(bf16_t, XN, WS_XN); DEFP(float, XR, WS_XR);
        for (int row = gw; row < MT; row += NGW) {
            const int cnd = row >= SEQ ? 1 : 0;
            norm_mod_row(XR + (size_t)row * DM, MOD(1, cnd, 0), MOD(1, cnd, 1), XN + (size_t)row * DM, lane);
        }
    }
    grid.sync();

    {
        PHASE_BEGIN(); DEFP(bf16_t, XN, WS_XN); DEFP(bf16_t, W_QKV1, WS_WQKV1); DEFP(float, QKVRAW, WS_QKVRAW);
        pg8::Gemm g{XN, W_QKV1, MT, DIN, DM, DM, DM, 0}; pg8::StaticOrder S; S.init(MT, DIN, G, bx);
        pg8::EpiF32 E{QKVRAW, DIN};
        pg8::gemm_phase<pg8::EpiF32, true, true>(lds, g, S, E, tid);
    }
    grid.sync();

    {
        PHASE_BEGIN(); DEFP(float, QKVRAW, WS_QKVRAW); DEFP(bf16_t, Qb, WS_Q); DEFP(bf16_t, Kb, WS_K); DEFP(bf16_t, Vb, WS_V);
        const int ax = lane >> 5, fi = lane & 31, d1 = ax * 64 + fi, d2 = d1 + 32;
        const float freq = exp2f(-(float)fi * (13.287712379549449f / 32.0f));
        const float gq1 = p.in[19][d1], gq2 = p.in[19][d2], gk1 = p.in[20][d1], gk2 = p.in[20][d2];
        for (int row = gw; row < MT; row += NGW) {
            const bool isc = row >= SEQ; const float* src = QKVRAW + (size_t)row * DIN;
            float cs = 1.f, sn = 0.f;
            if (!isc) { const float pos = (float)(ax == 0 ? (row >> 6) : (row & 63)); const float ang = pos * freq; cs = cosf(ang); sn = sinf(ang); }
            const int krow = isc ? row - SEQ : CTX + row;
            if (!isc) {
                for (int h = 0; h < 16; ++h) { const float x1 = src[h * 128 + d1], x2 = src[h * 128 + d2];
                    const float rstd = 1.0f / sqrtf(wave_sum(x1 * x1 + x2 * x2) * (1.f / 128.f) + EPS);
                    const float y1 = x1 * rstd * gq1, y2 = x2 * rstd * gq2;
                    const float o1 = y1 * cs - y2 * sn, o2 = y1 * sn + y2 * cs;
                    const unsigned pk = cvt_pk_bf16(o1, o2);
                    Qb[(size_t)row * DM + h * 128 + d1] = (bf16_t)(pk & 0xffffu); Qb[(size_t)row * DM + h * 128 + d2] = (bf16_t)(pk >> 16); }
            }
            for (int h = 0; h < 4; ++h) { const float x1 = src[2048 + h * 128 + d1], x2 = src[2048 + h * 128 + d2];
                const float rstd = 1.0f / sqrtf(wave_sum(x1 * x1 + x2 * x2) * (1.f / 128.f) + EPS);
                const float y1 = x1 * rstd * gk1, y2 = x2 * rstd * gk2;
                const float o1 = y1 * cs - y2 * sn, o2 = y1 * sn + y2 * cs;
                const unsigned pk = cvt_pk_bf16(o1, o2);
                Kb[(size_t)krow * 512 + h * 128 + d1] = (bf16_t)(pk & 0xffffu); Kb[(size_t)krow * 512 + h * 128 + d2] = (bf16_t)(pk >> 16);
                const unsigned pv = cvt_pk_bf16(src[2560 + h * 128 + d1], src[2560 + h * 128 + d2]);
                Vb[(size_t)krow * 512 + h * 128 + d1] = (bf16_t)(pv & 0xffffu); Vb[(size_t)krow * 512 + h * 128 + d2] = (bf16_t)(pv >> 16); }
        }
    }
    grid.sync();

    {
        PHASE_BEGIN(); DEFP(bf16_t, Qb, WS_Q); DEFP(bf16_t, Kb, WS_K); DEFP(bf16_t, Vb, WS_V); DEFP(bf16_t, Ob, WS_O);
        const int vcu = (G % 8 == 0) ? (bx % 8) * (G / 8) + bx / 8 : bx;
        for (int uidx = vcu; uidx < 16 * 32; uidx += G) {
            const int h = uidx >> 5, qb = uidx & 31, kvh = h >> 2;
            att::attn_dense_body((const att::bf16*)Qb + (size_t)qb * 256 * DM + h * 128, (const att::bf16*)Kb + kvh * 128, (const att::bf16*)Vb + kvh * 128,
                                 (att::bf16*)Ob + (size_t)qb * 256 * DM + h * 128, MT, (char*)lds_raw, tid);
        }
    }
    grid.sync();

    {
        PHASE_BEGIN(); DEFP(bf16_t, Ob, WS_O); DEFP(bf16_t, W_OUT1, WS_WOUT1); DEFP(float, XR, WS_XR);
        pg8::Gemm g{Ob, W_OUT1, SEQ, DM, DM, DM, DM, 0}; pg8::StaticOrder S; S.init(SEQ, DM, G, bx);
        pg8::EpiRes E{XR, XR, MOD(1, 0, 2), MOD(1, 0, 2), XR};
        pg8::gemm_phase<pg8::EpiRes, true, true>(lds, g, S, E, tid);
    }
    grid.sync();

    {
        PHASE_BEGIN(); DEFP(bf16_t, XN, WS_XN); DEFP(float, XR, WS_XR);
        for (int row = gw; row < SEQ; row += NGW) norm_mod_row(XR + (size_t)row * DM, MOD(1, 0, 3), MOD(1, 0, 4), XN + (size_t)row * DM, lane);
    }
    grid.sync();

    {
        PHASE_BEGIN(); DEFP(bf16_t, XN, WS_XN); DEFP(bf16_t, W_UP1, WS_WUP1); DEFP(bf16_t, H, WS_R);
        pg8::Gemm g{XN, W_UP1, SEQ, DFF, DM, DM, DM, 0}; pg8::StaticOrder S; S.init(SEQ, DFF, G, bx);
        pg8::EpiBf16<1, false> E{H, DFF, 0, nullptr};
        pg8::gemm_phase<pg8::EpiBf16<1, false>, true, true>(lds, g, S, E, tid);
    }
    grid.sync();

    {
        PHASE_BEGIN(); DEFP(bf16_t, H, WS_R); DEFP(bf16_t, W_DN1, WS_WDN1); DEFP(float, XR, WS_XR);
        pg8::Gemm g{H, W_DN1, SEQ, DM, DFF, DFF, DFF, 0}; pg8::StaticOrder S; S.init(SEQ, DM, G, bx);
        pg8::EpiRes E{XR, XR, MOD(1, 0, 5), MOD(1, 0, 5), XR};
        pg8::gemm_phase<pg8::EpiRes, true, true>(lds, g, S, E, tid);
    }
    grid.sync();

    {
        PHASE_BEGIN(); DEFP(float, XR, WS_XR);
        for (int row = gw; row < SEQ; row += NGW) {
            const f32x4* xr = (const f32x4*)(XR + (size_t)row * DM) + lane; f32x4 v[8]; float s = 0.f;
#pragma unroll
            for (int j = 0; j < 8; ++j) { v[j] = xr[64 * j]; s += (v[j].x * v[j].x + v[j].y * v[j].y) + (v[j].z * v[j].z + v[j].w * v[j].w); }
            const float rstd = 1.0f / sqrtf(wave_sum(s) * (1.f / DM) + EPS);
            f32x4* o = (f32x4*)(p.out + (size_t)row * DM) + lane;
#pragma unroll
            for (int j = 0; j < 8; ++j) o[64 * j] = v[j] * rstd * ((const f32x4*)p.in[24])[lane + 64 * j];
        }
    }
#undef MOD
}

extern "C" void kernel_launch(void* const* d_in, const int* in_sizes, int n_in, void* d_out, int out_size, void* d_ws, size_t ws_size, hipStream_t stream) {
    static int grid = 0;
    if (grid == 0) {
        if (n_in != 25 || ws_size < WS_END) { fprintf(stderr, "kernel_launch: n_in %d ws %zu (need 25, >= %zu)\n", n_in, ws_size, (size_t)WS_END); }
        int dev = 0, cus = 0, per_cu = 0;
        hipGetDevice(&dev);
        hipDeviceGetAttribute(&cus, hipDeviceAttributeMultiprocessorCount, dev);
        hipFuncSetAttribute((const void*)fwd_mega, hipFuncAttributeMaxDynamicSharedMemorySize, LDS_BYTES);
        hipOccupancyMaxActiveBlocksPerMultiprocessor(&per_cu, (const void*)fwd_mega, 512, LDS_BYTES);
        (void)hipGetLastError();
        if (per_cu < 1) { fprintf(stderr, "kernel_launch: occupancy query says %d blocks per CU\n", per_cu); per_cu = 1; }
        grid = cus;
    }
    Params p{};
    for (int i = 0; i < 25; ++i) p.in[i] = (const float*)d_in[i];
    p.out = (float*)d_out; p.ws = (unsigned char*)d_ws;
    void* args[] = {&p};
    hipError_t e = hipLaunchCooperativeKernel((const void*)fwd_mega, dim3(grid), dim3(512), args, LDS_BYTES, stream);
    if (e != hipSuccess) fprintf(stderr, "cooperative launch failed: %s (grid %d)\n", hipGetErrorString(e), grid);
}
```

```cpp
#include <hip/hip_runtime.h>
#include <hip/hip_cooperative_groups.h>
#include <hip/hip_bf16.h>
#include <cstdio>
#include <cstdint>
namespace cg = cooperative_groups;

#define LAS __attribute__((address_space(3)))
typedef unsigned short bf16_t;
typedef short bf16x8 __attribute__((ext_vector_type(8)));
typedef short s16x4 __attribute__((ext_vector_type(4)));
typedef float f32x4 __attribute__((ext_vector_type(4)));
typedef float f32x2 __attribute__((ext_vector_type(2)));
typedef float f32x16 __attribute__((ext_vector_type(16)));
typedef unsigned u32x4 __attribute__((ext_vector_type(4)));
typedef unsigned u32x2 __attribute__((ext_vector_type(2)));

constexpr int DM = 2048, SEQ = 8192, CTX = 256, MT = SEQ + CTX  , DFF = 8192, DIN = 3072;
constexpr int NMODV = 6 * DM;
constexpr float EPS = 1e-6f;

constexpr size_t MiB = 1u << 20;
constexpr size_t WS_BAR = 65536, WS_CTL_BYTES = 262144;
constexpr size_t WS_MODS = 1 * MiB;
constexpr size_t WS_WIN0 = 2 * MiB, WS_WOUT0 = 14 * MiB, WS_WUP0 = 22 * MiB, WS_WDN0 = 54 * MiB;
constexpr size_t WS_WQKV1 = 86 * MiB, WS_WOUT1 = 98 * MiB, WS_WUP1 = 106 * MiB, WS_WDN1 = 138 * MiB, WS_WPOOL = 170 * MiB;
constexpr size_t WS_XR = 172 * MiB;
constexpr size_t WS_XN = 238 * MiB;
constexpr size_t WS_R = 272 * MiB;
constexpr size_t WS_GLU = WS_R, WS_U = WS_R + 33 * MiB, WS_YC = WS_R + 66 * MiB, WS_D = WS_R + 99 * MiB;
constexpr size_t WS_Q = WS_R, WS_K = WS_R + 32 * MiB, WS_V = WS_R + 41 * MiB, WS_O = WS_R + 50 * MiB;
constexpr size_t WS_QKVRAW = 404 * MiB;
constexpr size_t WS_END = 504 * MiB;

constexpr int LDS_BYTES = 147456;

__device__ __forceinline__ unsigned cvt_pk_bf16(float lo, float hi) { unsigned r; asm volatile("v_cvt_pk_bf16_f32 %0, %1, %2" : "=v"(r) : "v"(lo), "v"(hi)); return r; }
__device__ __forceinline__ float wave_sum(float v) {
#pragma unroll
    for (int o = 1; o < 64; o <<= 1) v += __shfl_xor(v, o);
    return v;
}
__device__ __forceinline__ float sigmoidf_(float g) { return 1.0f / (1.0f + __expf(-g)); }

namespace pg8 {
constexpr int BM = 256, BK = 64, HALF = 128, HTB = HALF * BK * 2, STAGE_BYTES = 8 * HTB, NXCD = 8, WGM = 8;
__host__ __device__ __forceinline__ int lds_byte(int r, int c) { const int st = (r >> 4) * 2 + (c >> 5), rr = r & 15, cc = c & 31, ob = rr * 64 + cc * 2; return st * 1024 + (ob ^ (((ob >> 9) & 1) << 5)); }
__host__ __device__ __forceinline__ void stage_rc(int b, int& R, int& C) { const int st = b / 1024, sb = b % 1024, swz = sb ^ (((sb >> 9) & 1) << 5); R = (st >> 1) * 16 + swz / 64; C = (st & 1) * 32 + (swz % 64) / 2; }
__host__ __device__ __forceinline__ int perm32(int rho) { const int n = rho >> 4, i = rho & 15; return 8 * (i >> 2) + 4 * n + (i & 3); }

struct Unit { int pm, pn; };
struct Gemm { const bf16_t* A; const bf16_t* Bt; int M, N, K, lda, ldb, a_pn_off; };

struct StaticOrder {
    int nM, nN, nwg, G, c;
    __host__ __device__ void init(int M, int N, int G_, int c_) { nM = M / BM; nN = N / BM; nwg = nM * nN; G = G_; c = c_; }
    __host__ __device__ bool next(int i, Unit& u) const {
        const long L = (long)i * G + c; if (L >= nwg) return false;
        int wgid = (int)L; { const int q = nwg / NXCD, r = nwg % NXCD, xcd = wgid % NXCD, off = wgid / NXCD; wgid = (xcd < r ? xcd * (q + 1) : r * (q + 1) + (xcd - r) * q) + off; }
        const int nig = WGM * nN, gid = wgid / nig, fm = gid * WGM, gsz = (nM - fm) < WGM ? (nM - fm) : WGM;
        u.pm = fm + ((wgid % nig) % gsz); u.pn = (wgid % nig) / gsz; return true;
    }
};

typedef f32x4 Acc[2][2][4][2];

template <int ACT, bool HAS_SCALE> struct EpiBf16 {
    static constexpr bool PERM = true;
    bf16_t* O; int ldc; int col_off; const float* scale;
    __device__ __forceinline__ void operator()(const Acc& acc, const Unit& u, int wr, int wc, int fr, int fq) const {
        const int row0 = u.pm * BM + wr * 64 + fr; const int col0 = u.pn * BM + wc * 32 + 8 * fq;
        f32x4 sv[2][2];
        if constexpr (HAS_SCALE) {
#pragma unroll
        for (int bj = 0; bj < 2; ++bj)
#pragma unroll
            for (int n = 0; n < 2; ++n) sv[bj][n] = *(const f32x4*)(scale + col0 + bj * HALF + 4 * n);
        }
#pragma unroll
        for (int ai = 0; ai < 2; ++ai)
#pragma unroll
            for (int m = 0; m < 4; ++m) { bf16_t* rowp = O + (size_t)(row0 + ai * HALF + m * 16) * ldc + col_off + col0;
#pragma unroll
                for (int bj = 0; bj < 2; ++bj) { f32x4 v0 = acc[ai][bj][m][0], v1 = acc[ai][bj][m][1];
                    if (ACT == 1) { v0 = __builtin_elementwise_max(v0, (f32x4){0.f, 0.f, 0.f, 0.f}); v1 = __builtin_elementwise_max(v1, (f32x4){0.f, 0.f, 0.f, 0.f}); v0 = v0 * v0; v1 = v1 * v1; }
                    if constexpr (HAS_SCALE) { v0 = v0 * sv[bj][0]; v1 = v1 * sv[bj][1]; }
                    u32x4 w; w.x = cvt_pk_bf16(v0[0], v0[1]); w.y = cvt_pk_bf16(v0[2], v0[3]); w.z = cvt_pk_bf16(v1[0], v1[1]); w.w = cvt_pk_bf16(v1[2], v1[3]);
                    *(u32x4*)(rowp + bj * HALF) = w; } }
    }
};
struct EpiF32 {
    static constexpr bool PERM = false;
    float* O; int ldc;
    __device__ __forceinline__ void operator()(const Acc& acc, const Unit& u, int wr, int wc, int fr, int fq) const {
        const int row0 = u.pm * BM + wr * 64 + fr; const int col0 = u.pn * BM + wc * 32 + 4 * fq;
#pragma unroll
        for (int ai = 0; ai < 2; ++ai)
#pragma unroll
            for (int m = 0; m < 4; ++m) { float* rowp = O + (size_t)(row0 + ai * HALF + m * 16) * ldc + col0;
#pragma unroll
                for (int bj = 0; bj < 2; ++bj)
#pragma unroll
                    for (int n = 0; n < 2; ++n) *(f32x4*)(rowp + bj * HALF + n * 16) = acc[ai][bj][m][n]; }
    }
};
struct EpiGlu {
    static constexpr bool PERM = false;
    float* GLU; float* U;
    __device__ __forceinline__ void operator()(const Acc& acc, const Unit& u, int wr, int wc, int fr, int fq) const {
        const int row0 = u.pm * BM + wr * 64 + fr;
        if (u.pn < 8) {
            const int col0 = u.pn * 128 + wc * 32 + 4 * fq;
#pragma unroll
            for (int ai = 0; ai < 2; ++ai)
#pragma unroll
                for (int m = 0; m < 4; ++m) { float* rowp = GLU + (size_t)(row0 + ai * HALF + m * 16) * 1024 + col0;
#pragma unroll
                    for (int n = 0; n < 2; ++n) { const f32x4 a = acc[ai][0][m][n], g = acc[ai][1][m][n]; f32x4 o;
                        o[0] = a[0] * sigmoidf_(g[0]); o[1] = a[1] * sigmoidf_(g[1]); o[2] = a[2] * sigmoidf_(g[2]); o[3] = a[3] * sigmoidf_(g[3]);
                        *(f32x4*)(rowp + n * 16) = o; } }
        } else {
            const int col0 = (u.pn - 8) * BM + wc * 32 + 4 * fq;
#pragma unroll
            for (int ai = 0; ai < 2; ++ai)
#pragma unroll
                for (int m = 0; m < 4; ++m) { float* rowp = U + (size_t)(row0 + ai * HALF + m * 16) * 1024 + col0;
#pragma unroll
                    for (int bj = 0; bj < 2; ++bj)
#pragma unroll
                        for (int n = 0; n < 2; ++n) *(f32x4*)(rowp + bj * HALF + n * 16) = acc[ai][bj][m][n]; }
        }
    }
};
struct EpiRes {
    static constexpr bool PERM = false;
    const float* baseL; const float* baseC; const float* gateL; const float* gateC; float* out;
    __device__ __forceinline__ void operator()(const Acc& acc, const Unit& u, int wr, int wc, int fr, int fq) const {
        const bool isc = u.pm >= 32;
        const int row0 = u.pm * BM + wr * 64 + fr; const int col0 = u.pn * BM + wc * 32 + 4 * fq;
        const float* gate = isc ? gateC : gateL;
        const float* base = isc ? baseC + (size_t)(row0 - SEQ) * DM : baseL + (size_t)row0 * DM;
        f32x4 gv[2][2];
#pragma unroll
        for (int bj = 0; bj < 2; ++bj)
#pragma unroll
            for (int n = 0; n < 2; ++n) gv[bj][n] = *(const f32x4*)(gate + col0 + bj * HALF + n * 16);
#pragma unroll
        for (int ai = 0; ai < 2; ++ai)
#pragma unroll
            for (int m = 0; m < 4; ++m) { const size_t ro = (size_t)(ai * HALF + m * 16) * DM + col0; float* op = out + (size_t)row0 * DM + ro;
#pragma unroll
                for (int bj = 0; bj < 2; ++bj)
#pragma unroll
                    for (int n = 0; n < 2; ++n) { const f32x4 b = *(const f32x4*)(base + ro + bj * HALF + n * 16);
                        *(f32x4*)(op + bj * HALF + n * 16) = b + gv[bj][n] * acc[ai][bj][m][n]; } }
    }
};

template <class Epi, bool ALIGN_EPI, bool SP2>
__device__ __forceinline__ void gemm_phase(LAS unsigned char* lds, const Gemm g, const StaticOrder& S, const Epi& E, const int tid) {
    const int wid = __builtin_amdgcn_readfirstlane(tid >> 6), lane = tid & 63, wr = wid >> 2, wc = wid & 3, fr = lane & 15, fq = lane >> 4;
    const int K = g.K, nt = K / BK;
    unsigned voffA[2], voffB[2];
#pragma unroll
    for (int i = 0; i < 2; ++i) { int R, C; stage_rc(tid * 16 + i * 8192, R, C); const int Rb = Epi::PERM ? ((R & ~31) + perm32(R & 31)) : R;
        voffA[i] = (unsigned)(R * g.lda + C) * 2u; voffB[i] = (unsigned)(Rb * g.ldb + C) * 2u; }
    const size_t kstep = (size_t)(BK * 2);
    const size_t hstepA = (size_t)HALF * g.lda * 2, hstepB = (size_t)HALF * g.ldb * 2;
    const unsigned ldsw = (unsigned)wid * 1024u;
    const int aoff = lds_byte(wr * 64 + fr, fq * 8), boff = lds_byte(wc * 32 + fr, fq * 8);
#define PG8_UA(u_) ((const char*)g.A + ((size_t)(u_).pm * BM * g.lda + (size_t)(u_).pn * g.a_pn_off) * 2)
#define PG8_UB(u_) ((const char*)g.Bt + (size_t)(u_).pn * BM * g.ldb * 2)
#define PG8_SA(b, h) (((b) * 2 + (h)) * HTB)
#define PG8_SB(b, h) ((4 + (b) * 2 + (h)) * HTB)
#define PG8_STAGE(bufoff, gbase, voff) do { _Pragma("unroll") for (int _i = 0; _i < 2; ++_i) \
        __builtin_amdgcn_global_load_lds((const unsigned*)((const char*)(gbase) + (voff)[_i]), (LAS unsigned*)(lds + (bufoff) + ldsw + _i * 8192), 16, 0, 0); } while (0)
#define PG8_LDA(dst, b, h) do { _Pragma("unroll") for (int m = 0; m < 4; ++m) _Pragma("unroll") for (int k = 0; k < 2; ++k) dst[m][k] = *(const LAS bf16x8*)(lds + PG8_SA(b, h) + aoff + m * 2048 + k * 1024); } while (0)
#define PG8_LDB(dst, b, h) do { _Pragma("unroll") for (int n = 0; n < 2; ++n) _Pragma("unroll") for (int k = 0; k < 2; ++k) dst[n][k] = *(const LAS bf16x8*)(lds + PG8_SB(b, h) + boff + n * 2048 + k * 1024); } while (0)
#define PG8_MMA(ai, bj, At, Bt) do { __builtin_amdgcn_s_setprio(1); _Pragma("unroll") for (int m = 0; m < 4; ++m) _Pragma("unroll") for (int n = 0; n < 2; ++n) _Pragma("unroll") for (int k = 0; k < 2; ++k) \
        acc[ai][bj][m][n] = __builtin_amdgcn_mfma_f32_16x16x32_bf16(Bt[n][k], At[m][k], acc[ai][bj][m][n], 0, 0, 0); __builtin_amdgcn_s_setprio(0); } while (0)
#define PG8_WAIT_V(n) asm volatile("s_waitcnt vmcnt(" #n ")" ::: "memory")
#define PG8_WAIT_L(n) asm volatile("s_waitcnt lgkmcnt(" #n ")" ::: "memory")
#define PG8_BAR __builtin_amdgcn_s_barrier()
#define PG8_SCHED __builtin_amdgcn_sched_barrier(0)
    Unit cur, nxt; int ui = 0;
    if (!S.next(0, cur)) return;
    f32x4 acc[2][2][4][2];
#pragma unroll
    for (int a = 0; a < 2; ++a)
#pragma unroll
        for (int b = 0; b < 2; ++b)
#pragma unroll
            for (int m = 0; m < 4; ++m)
#pragma unroll
                for (int n = 0; n < 2; ++n) acc[a][b][m][n] = (f32x4){0.f, 0.f, 0.f, 0.f};
    bf16x8 At[4][2], B0[2][2], B1[2][2];
    const char* cA = PG8_UA(cur); const char* cB = PG8_UB(cur);
    if constexpr (SP2) {
        PG8_STAGE(PG8_SB(0, 0), cB, voffB); PG8_STAGE(PG8_SB(0, 1), cB + hstepB, voffB); PG8_STAGE(PG8_SA(0, 0), cA, voffA); PG8_STAGE(PG8_SA(0, 1), cA + hstepA, voffA);
        if (wr == 1) PG8_BAR;
        PG8_WAIT_V(2); PG8_BAR;
        PG8_STAGE(PG8_SB(1, 0), cB + kstep, voffB); PG8_STAGE(PG8_SA(1, 0), cA + kstep, voffA); PG8_STAGE(PG8_SB(1, 1), cB + hstepB + kstep, voffB);
        PG8_WAIT_V(6); PG8_BAR;
    } else {
        PG8_STAGE(PG8_SB(0, 0), cB, voffB); PG8_STAGE(PG8_SA(0, 0), cA, voffA); PG8_STAGE(PG8_SB(0, 1), cB + hstepB, voffB); PG8_STAGE(PG8_SA(0, 1), cA + hstepA, voffA);
        if (wr == 1) PG8_BAR;
        PG8_WAIT_V(4); PG8_BAR;
        PG8_STAGE(PG8_SB(1, 0), cB + kstep, voffB); PG8_STAGE(PG8_SA(1, 0), cA + kstep, voffA); PG8_STAGE(PG8_SB(1, 1), cB + hstepB + kstep, voffB);
        PG8_WAIT_V(6); PG8_BAR;
    }
    for (;;) {
        const bool has_next = S.next(ui + 1, nxt);
        const char* nA = has_next ? PG8_UA(nxt) : cA; const char* nB = has_next ? PG8_UB(nxt) : cB;
        for (int t = 0; t < nt; t += 2) {
            const bool last = (t == nt - 2);
            const char* a1 = cA + (size_t)(t + 1) * kstep;
            const char* a2 = last ? nA : cA + (size_t)(t + 2) * kstep; const char* b2 = last ? nB : cB + (size_t)(t + 2) * kstep;
            const char* a3 = a2 + kstep; const char* b3 = b2 + kstep;
            if constexpr (SP2) {
            PG8_LDB(B0, 0, 0); PG8_LDB(B1, 0, 1); PG8_SCHED; PG8_LDA(At, 0, 0); PG8_STAGE(PG8_SA(1, 1), a1 + hstepA, voffA);
            PG8_WAIT_V(8); PG8_WAIT_L(0); PG8_BAR; PG8_MMA(0, 0, At, B0); PG8_MMA(0, 1, At, B1); PG8_BAR; PG8_SCHED;
            PG8_LDA(At, 0, 1); PG8_STAGE(PG8_SB(0, 0), b2, voffB); PG8_STAGE(PG8_SB(0, 1), b2 + hstepB, voffB); PG8_STAGE(PG8_SA(0, 0), a2, voffA);
            PG8_WAIT_V(8); PG8_WAIT_L(0); PG8_BAR; PG8_MMA(1, 0, At, B0); PG8_MMA(1, 1, At, B1); PG8_BAR; PG8_SCHED;
            PG8_LDB(B0, 1, 0); PG8_LDB(B1, 1, 1); PG8_SCHED; PG8_LDA(At, 1, 0); PG8_STAGE(PG8_SA(0, 1), a2 + hstepA, voffA);
            PG8_WAIT_V(8); PG8_WAIT_L(0); PG8_BAR; PG8_MMA(0, 0, At, B0); PG8_MMA(0, 1, At, B1); PG8_BAR; PG8_SCHED;
            PG8_LDA(At, 1, 1); PG8_STAGE(PG8_SB(1, 0), b3, voffB); PG8_STAGE(PG8_SB(1, 1), b3 + hstepB, voffB); PG8_STAGE(PG8_SA(1, 0), a3, voffA);
            PG8_WAIT_V(8); PG8_WAIT_L(0); PG8_BAR; PG8_MMA(1, 0, At, B0); PG8_MMA(1, 1, At, B1); PG8_BAR; PG8_SCHED;
            } else {
            PG8_LDB(B0, 0, 0); PG8_SCHED; PG8_LDA(At, 0, 0); PG8_STAGE(PG8_SA(1, 1), a1 + hstepA, voffA);
            PG8_WAIT_L(8); PG8_BAR; PG8_WAIT_L(0); PG8_MMA(0, 0, At, B0); PG8_BAR; PG8_SCHED;
            PG8_LDB(B1, 0, 1); PG8_STAGE(PG8_SB(0, 0), b2, voffB);
            PG8_BAR; PG8_WAIT_L(0); PG8_MMA(0, 1, At, B1); PG8_BAR;
            PG8_LDA(At, 0, 1); PG8_STAGE(PG8_SA(0, 0), a2, voffA);
            PG8_BAR; PG8_WAIT_L(0); PG8_MMA(1, 0, At, B0); PG8_BAR; PG8_SCHED;
            PG8_STAGE(PG8_SB(0, 1), b2 + hstepB, voffB);
            PG8_WAIT_V(6); PG8_BAR; PG8_MMA(1, 1, At, B1); PG8_BAR;
            PG8_LDB(B0, 1, 0); PG8_SCHED; PG8_LDA(At, 1, 0); PG8_STAGE(PG8_SA(0, 1), a2 + hstepA, voffA);
            PG8_WAIT_L(8); PG8_BAR; PG8_WAIT_L(0); PG8_MMA(0, 0, At, B0); PG8_BAR; PG8_SCHED;
            PG8_LDB(B1, 1, 1); PG8_STAGE(PG8_SB(1, 0), b3, voffB);
            PG8_BAR; PG8_WAIT_L(0); PG8_MMA(0, 1, At, B1); PG8_BAR;
            PG8_LDA(At, 1, 1); PG8_STAGE(PG8_SA(1, 0), a3, voffA);
            PG8_BAR; PG8_WAIT_L(0); PG8_MMA(1, 0, At, B0); PG8_BAR; PG8_SCHED;
            PG8_STAGE(PG8_SB(1, 1), b3 + hstepB, voffB);
            PG8_WAIT_V(6); PG8_BAR; PG8_MMA(1, 1, At, B1); PG8_BAR;
            }
        }
        if constexpr (ALIGN_EPI) { if (wr == 0) PG8_BAR; }
        E(acc, cur, wr, wc, fr, fq);
        if (!has_next) break;
#pragma unroll
        for (int a = 0; a < 2; ++a)
#pragma unroll
            for (int b = 0; b < 2; ++b)
#pragma unroll
                for (int m = 0; m < 4; ++m)
#pragma unroll
                    for (int n = 0; n < 2; ++n) acc[a][b][m][n] = (f32x4){0.f, 0.f, 0.f, 0.f};
        cur = nxt; cA = nA; cB = nB; ++ui;
        if constexpr (ALIGN_EPI) { if (wr == 1) PG8_BAR; }
    }
    PG8_WAIT_V(0);
    if constexpr (!ALIGN_EPI) { if (wr == 0) PG8_BAR; }
    PG8_BAR;
#undef PG8_UA
#undef PG8_UB
#undef PG8_SA
#undef PG8_SB
#undef PG8_STAGE
#undef PG8_LDA
#undef PG8_LDB
#undef PG8_MMA
#undef PG8_WAIT_V
#undef PG8_WAIT_L
#undef PG8_BAR
#undef PG8_SCHED
}
}

namespace att {
using bf16 = __hip_bfloat16;
constexpr int D = 128, NW = 8, QBLK = 32, KVBLK = 64;
constexpr float SCALE = 0.088388347648318440f;
constexpr float THR = 8.f;
constexpr int LDQ = 2048, LDK = 512, LDO = 2048;
constexpr size_t SHM_V = KVBLK * D * 2, SHM_K = KVBLK * D * 2, SHM_ATTN = 2 * SHM_V + 2 * SHM_K + NW * 64 * 4;
#define KSWZ(row, colB) ((row) * 256 + ((colB) ^ (((row) & 7) << 4)))
#define SBAR() __builtin_amdgcn_sched_barrier(0)
__device__ __forceinline__ int crow(int r, int hi) { return (r & 3) + 8 * (r >> 2) + 4 * hi; }
__device__ __forceinline__ unsigned cvtpk(float lo, float hi) { unsigned r; asm volatile("v_cvt_pk_bf16_f32 %0, %1, %2" : "=v"(r) : "v"(lo), "v"(hi)); return r; }
__device__ __forceinline__ bf16x8 ld8(const bf16* p) { return *reinterpret_cast<const bf16x8*>(p); }

__device__ __forceinline__ void partialSM(f32x16& p0, f32x16& p1, float& m_reg, float& mn, float& alpha) {
  constexpr float C = SCALE * 1.4426950408889634f;
  float pmax = p0[0]; for (int r = 1; r < 16; ++r) pmax = fmaxf(pmax, p0[r]); for (int r = 0; r < 16; ++r) pmax = fmaxf(pmax, p1[r]);
  { auto rr = __builtin_amdgcn_permlane32_swap(__float_as_uint(pmax), __float_as_uint(pmax), false, false);
    pmax = fmaxf(__uint_as_float(rr[0]), __uint_as_float(rr[1])); }
  if (__builtin_expect(__all(pmax - m_reg <= THR / SCALE), 1)) { mn = m_reg; alpha = 1.f; }
  else { mn = fmaxf(m_reg, pmax); alpha = __builtin_amdgcn_exp2f((m_reg - mn) * C); m_reg = mn; }
  float mnC = -mn * C;
  for (int r = 0; r < 16; ++r) p0[r] = fmaf(p0[r], C, mnC); for (int r = 0; r < 16; ++r) p1[r] = fmaf(p1[r], C, mnC);
  for (int r = 0; r < 16; ++r) p0[r] = __builtin_amdgcn_exp2f(p0[r]);
}
__device__ __forceinline__ void finishSM(f32x16& p0, f32x16& p1, float alpha, float& l_reg, bf16x8& pa0, bf16x8& pa1, bf16x8& pa2, bf16x8& pa3) {
  for (int r = 0; r < 16; ++r) p1[r] = __builtin_amdgcn_exp2f(p1[r]);
  float ps = 0; for (int r = 0; r < 16; ++r) ps += p0[r]; for (int r = 0; r < 16; ++r) ps += p1[r];
  { auto rr = __builtin_amdgcn_permlane32_swap(__float_as_uint(ps), __float_as_uint(ps), false, false);
    ps = __uint_as_float(rr[0]) + __uint_as_float(rr[1]); }
  l_reg = l_reg * alpha + ps;
#define PK4(P, BASE, OUT) do { unsigned a0 = cvtpk(P[BASE + 0], P[BASE + 1]), a1 = cvtpk(P[BASE + 2], P[BASE + 3]);   \
    unsigned b0 = cvtpk(P[BASE + 4], P[BASE + 5]), b1 = cvtpk(P[BASE + 6], P[BASE + 7]);                              \
    auto r0 = __builtin_amdgcn_permlane32_swap(a0, b0, false, false); auto r1 = __builtin_amdgcn_permlane32_swap(a1, b1, false, false); \
    u32x4 w = {r0[0], r1[0], r0[1], r1[1]}; OUT = *reinterpret_cast<bf16x8*>(&w); } while (0)
  PK4(p0, 0, pa0); PK4(p0, 8, pa1); PK4(p1, 0, pa2); PK4(p1, 8, pa3);
#undef PK4
}
__device__ __forceinline__ void qkt(f32x16& p0, f32x16& p1, const bf16* Ks, const bf16x8* qr, int r32, int hi) {
  p0 = f32x16{}; p1 = f32x16{};
  for (int d0 = 0; d0 < 8; ++d0) { int cb = (d0 * 16 + hi * 8) * 2;
    bf16x8 b0 = *reinterpret_cast<const bf16x8*>((const char*)Ks + KSWZ(r32, cb));
    bf16x8 b1 = *reinterpret_cast<const bf16x8*>((const char*)Ks + KSWZ(32 + r32, cb));
    p0 = __builtin_amdgcn_mfma_f32_32x32x16_bf16(b0, qr[d0], p0, 0, 0, 0);
    p1 = __builtin_amdgcn_mfma_f32_32x32x16_bf16(b1, qr[d0], p1, 0, 0, 0); }
}
__device__ __forceinline__ int v_st(int k, int c) { const int kk = (k & ~0xC) | ((k & 4) << 1) | ((k & 8) >> 1); return ((kk >> 3) * 4 + (c >> 5)) * 512 + ((kk & 7) * 32 + (c & 31)) * 2; }
__device__ __forceinline__ int v_rd_base(int lane) { return ((lane & 3) << 3) | (((lane >> 2) & 3) << 6) | (((lane >> 4) & 1) << 5) | (((lane >> 5) & 1) << 8); }
constexpr int v_rd_off(int d0, int ks, int half) { return d0 * 512 + ks * 4096 + half * 2048; }
template <int OFF> __device__ __forceinline__ s16x4 tr_read(int vb) {
  s16x4 r; asm volatile("ds_read_b64_tr_b16 %0, %1 offset:%2" : "=&v"(r) : "v"(vb), "i"(OFF) : "memory"); return r;
}
template <int D0> __device__ __forceinline__ void pv_one(f32x16& od, int vb, bf16x8 pa0, bf16x8 pa1, bf16x8 pa2, bf16x8 pa3) {
  const s16x4 l0 = tr_read<v_rd_off(D0, 0, 0)>(vb), h0 = tr_read<v_rd_off(D0, 0, 1)>(vb), l1 = tr_read<v_rd_off(D0, 1, 0)>(vb), h1 = tr_read<v_rd_off(D0, 1, 1)>(vb);
  const s16x4 l2 = tr_read<v_rd_off(D0, 2, 0)>(vb), h2 = tr_read<v_rd_off(D0, 2, 1)>(vb), l3 = tr_read<v_rd_off(D0, 3, 0)>(vb), h3 = tr_read<v_rd_off(D0, 3, 1)>(vb);
  asm volatile("s_waitcnt lgkmcnt(0)" ::: "memory"); SBAR();
#define PK(L, H) (bf16x8){L[0], L[1], L[2], L[3], H[0], H[1], H[2], H[3]}
  od = __builtin_amdgcn_mfma_f32_32x32x16_bf16(pa0, PK(l0, h0), od, 0, 0, 0);
  od = __builtin_amdgcn_mfma_f32_32x32x16_bf16(pa1, PK(l1, h1), od, 0, 0, 0);
  od = __builtin_amdgcn_mfma_f32_32x32x16_bf16(pa2, PK(l2, h2), od, 0, 0, 0);
  od = __builtin_amdgcn_mfma_f32_32x32x16_bf16(pa3, PK(l3, h3), od, 0, 0, 0);
#undef PK
}
__device__ __forceinline__ void pv_d0(f32x16* o, int vb, bf16x8 pa0, bf16x8 pa1, bf16x8 pa2, bf16x8 pa3) {
  pv_one<0>(o[0], vb, pa0, pa1, pa2, pa3); pv_one<1>(o[1], vb, pa0, pa1, pa2, pa3); pv_one<2>(o[2], vb, pa0, pa1, pa2, pa3); pv_one<3>(o[3], vb, pa0, pa1, pa2, pa3);
}

__device__ __forceinline__ void attn_dense_body(const bf16* __restrict__ Qb, const bf16* __restrict__ Kh, const bf16* __restrict__ Vh,
                                                bf16* __restrict__ Ob, int seq, char* lds, const int tid) {
  const int wid = tid >> 6, lane = tid & 63, r32 = lane & 31, hi = lane >> 5;
  bf16* V_lds = (bf16*)lds; bf16* K_lds = (bf16*)(lds + 2 * SHM_V);
  float* ws = (float*)(lds + 2 * SHM_V + 2 * SHM_K) + wid * 64; float* li_l = ws; float* al_l = ws + 32;
  float m_reg = -1e30f, l_reg = 0; f32x16 o[4] = {}; bf16x8 qr[8];
  const bf16* Qw = Qb + (long)(wid * QBLK + r32) * LDQ + hi * 8;
#pragma unroll
  for (int d0 = 0; d0 < 8; ++d0) qr[d0] = ld8(Qw + d0 * 16);
  const int sr = tid >> 4, sc = (tid & 15) * 8, vst0 = v_st(sr, sc), vst1 = v_st(32 + sr, sc);
  const int vb0 = (int)(uintptr_t)V_lds + v_rd_base(lane);
  struct { bf16x8 vs0, vs1, ks0, ks1; } sr_[2];
#define SLOAD(i, k0) do { sr_[i].vs0 = ld8(&Vh[(long)((k0) + sr) * LDK + sc]); sr_[i].vs1 = ld8(&Vh[(long)((k0) + 32 + sr) * LDK + sc]); \
    sr_[i].ks0 = ld8(&Kh[(long)((k0) + sr) * LDK + sc]); sr_[i].ks1 = ld8(&Kh[(long)((k0) + 32 + sr) * LDK + sc]); } while (0)
#define SWRITE(b, i) do { *(bf16x8*)((char*)V_lds + (b) * SHM_V + vst0) = sr_[i].vs0;          \
    *(bf16x8*)((char*)V_lds + (b) * SHM_V + vst1) = sr_[i].vs1; int kc = sc * 2;               \
    *(bf16x8*)((char*)K_lds + (b) * SHM_K + KSWZ(sr, kc)) = sr_[i].ks0;                       \
    *(bf16x8*)((char*)K_lds + (b) * SHM_K + KSWZ(32 + sr, kc)) = sr_[i].ks1; } while (0)
#define SWAIT() asm volatile("s_waitcnt vmcnt(4)" ::: "memory")
#define RESC(a) do { if (__any((a) < 1.f)) { if (hi == 0) al_l[r32] = (a); asm volatile("s_waitcnt lgkmcnt(0)" ::: "memory"); \
    for (int d = 0; d < 4; ++d) for (int r = 0; r < 16; ++r) o[d][r] *= al_l[crow(r, hi)]; } } while (0)
  f32x16 pA0, pA1, pB0, pB1; float mnA, mnB, alA, alB; bf16x8 pa0, pa1, pa2, pa3; const int NT = seq / KVBLK;
  constexpr int SE = 0, SO = 1;
  SLOAD(SE, 0); asm volatile("s_waitcnt vmcnt(0)" ::: "memory"); SWRITE(0, SE); __syncthreads();
  qkt(pA0, pA1, K_lds, qr, r32, hi); partialSM(pA0, pA1, m_reg, mnA, alA);
  SLOAD(SO, KVBLK); if (2 < NT) SLOAD(SE, 2 * KVBLK);
  SWAIT(); SWRITE(1, SO); __syncthreads();
  for (int j = 1; j + 1 < NT; j += 2) {
    SBAR(); qkt(pB0, pB1, (bf16*)((char*)K_lds + SHM_K), qr, r32, hi);
    finishSM(pA0, pA1, alA, l_reg, pa0, pa1, pa2, pa3); SBAR();
    SLOAD(SO, (j + 2) * KVBLK); SBAR();
    pv_d0(o, vb0, pa0, pa1, pa2, pa3); partialSM(pB0, pB1, m_reg, mnB, alB);
    __syncthreads(); SWAIT(); SWRITE(0, SE);
    RESC(alB); __syncthreads();
    SBAR(); qkt(pA0, pA1, K_lds, qr, r32, hi);
    finishSM(pB0, pB1, alB, l_reg, pa0, pa1, pa2, pa3); SBAR();
    if (j + 3 < NT) SLOAD(SE, (j + 3) * KVBLK); SBAR();
    pv_d0(o, vb0 + (int)SHM_V, pa0, pa1, pa2, pa3); partialSM(pA0, pA1, m_reg, mnA, alA);
    __syncthreads(); SWAIT(); SWRITE(1, SO);
    RESC(alA); __syncthreads();
  }
  SBAR(); qkt(pB0, pB1, (bf16*)((char*)K_lds + SHM_K), qr, r32, hi);
  finishSM(pA0, pA1, alA, l_reg, pa0, pa1, pa2, pa3); SBAR();
  pv_d0(o, vb0, pa0, pa1, pa2, pa3); partialSM(pB0, pB1, m_reg, mnB, alB);
  __syncthreads(); RESC(alB);
  finishSM(pB0, pB1, alB, l_reg, pa0, pa1, pa2, pa3); SBAR();
  pv_d0(o, vb0 + (int)SHM_V, pa0, pa1, pa2, pa3);
  if (hi == 0) li_l[r32] = l_reg; asm volatile("s_waitcnt lgkmcnt(0)" ::: "memory");
  float rli[16];
#pragma unroll
  for (int r = 0; r < 16; ++r) rli[r] = __builtin_amdgcn_rcpf(li_l[crow(r, hi)]);
  bf16* Ow = Ob + (long)(wid * QBLK) * LDO;
#pragma unroll
  for (int r = 0; r < 16; ++r) { int orow = crow(r, hi);
    for (int d0 = 0; d0 < 4; ++d0) Ow[(long)orow * LDO + d0 * 32 + r32] = __float2bfloat16(o[d0][r] * rli[r]); }
  __syncthreads();
#undef SLOAD
#undef SWRITE
#undef SWAIT
#undef RESC
}
#undef KSWZ
#undef SBAR
}

#define XB_TMO      128
#define XB_XCNT(j)  (256  + 64 * (j))
#define XB_XSUB(j)  (1280 + 64 * (j))
#define XB_XGEN(j)  (2304 + 64 * (j))
#define XB_TOP      3328
#define XB_TOPGEN   3392
#define XCD_BAR_WORDS 3456
#define XB_SPIN_CAP (1u << 18)
__device__ __forceinline__ unsigned xb_ld(unsigned* p)              { return __hip_atomic_load(p, __ATOMIC_RELAXED, __HIP_MEMORY_SCOPE_AGENT); }
__device__ __forceinline__ unsigned xb_add(unsigned* p, unsigned v) { return __hip_atomic_fetch_add(p, v, __ATOMIC_RELAXED, __HIP_MEMORY_SCOPE_AGENT); }
__device__ __forceinline__ unsigned xb_xcc_id() { return (unsigned)__builtin_amdgcn_s_getreg((3 << 11) | 20) & 0xFu; }
#define XB_SPIN(cond, bar) do { unsigned _sp = 0; while (cond) { __builtin_amdgcn_s_sleep(1); \
    if ((++_sp & 255u) == 0u) { if (xb_ld(&(bar)[XB_TMO])) break; if (_sp > XB_SPIN_CAP) { atomicAdd(&(bar)[XB_TMO], 1u); break; } } } } while (0)
struct XcdBarrier { unsigned* bar; unsigned x; volatile LAS unsigned* st; };
__device__ __forceinline__ XcdBarrier xcd_barrier_post(unsigned* bar, volatile LAS unsigned* st) {
    XcdBarrier b; b.bar = bar; b.x = xb_xcc_id(); b.st = st;
    if (threadIdx.x == 0) (void)xb_add(&bar[XB_XCNT(b.x)], 1u);
    return b;
}
__device__ __forceinline__ void xcd_barrier_complete(unsigned* bar, unsigned x, unsigned& nloc, unsigned& nx) {
    const unsigned G = gridDim.x * gridDim.y * gridDim.z;
    unsigned sum, cnt, mine, sp = 0u;
    for (;;) {
        sum = 0u; cnt = 0u; mine = 0u;
#pragma unroll
        for (unsigned j = 0; j < 16; ++j) { const unsigned c = xb_ld(&bar[XB_XCNT(j)]); sum += c; cnt += (c > 0u) ? 1u : 0u; mine = (j == x) ? c : mine; }
        if (sum == G) break;
        __builtin_amdgcn_s_sleep(1);
        if ((++sp & 255u) == 0u) { if (xb_ld(&bar[XB_TMO])) break; if (sp > XB_SPIN_CAP) { atomicAdd(&bar[XB_TMO], 1u); break; } }
    }
    nloc = mine > 0u ? mine : 1u; nx = cnt > 0u ? cnt : 1u;
}
__device__ __forceinline__ void xcd_barrier(const XcdBarrier& b) {
    asm volatile("s_waitcnt vmcnt(0)" ::: "memory");
    __syncthreads();
    if (threadIdx.x == 0) {
        unsigned* bar = b.bar;
        __builtin_amdgcn_s_waitcnt(0);
        unsigned nloc = b.st[0], nx = b.st[1];
        if (nloc == 0u) { xcd_barrier_complete(bar, b.x, nloc, nx); b.st[0] = nloc; b.st[1] = nx; }
        const unsigned old = xb_add(&bar[XB_XSUB(b.x)], 1u);
        const unsigned gen = old / nloc;
        if (old + 1u == (gen + 1u) * nloc) {
            __builtin_amdgcn_fence(__ATOMIC_RELEASE, "agent");
            asm volatile("s_waitcnt vmcnt(0)" ::: "memory");
            const unsigned og = xb_add(&bar[XB_TOP], 1u);
            const unsigned tg = og / nx;
            if (og + 1u == (tg + 1u) * nx) xb_add(&bar[XB_TOPGEN], 1u);
            else XB_SPIN(xb_ld(&bar[XB_TOPGEN]) == tg, bar);
            __builtin_amdgcn_fence(__ATOMIC_ACQUIRE, "agent");
            xb_add(&bar[XB_XGEN(b.x)], 1u);
            asm volatile("s_waitcnt vmcnt(0)" ::: "memory");
        } else {
            XB_SPIN(xb_ld(&bar[XB_XGEN(b.x)]) == gen, bar);
            __builtin_amdgcn_fence(__ATOMIC_ACQUIRE, "agent");
            asm volatile("s_waitcnt vmcnt(0)" ::: "memory");
        }
    }
    __syncthreads();
}

__device__ __forceinline__ void transpose_item(const float* W, int K, int N, bf16_t* WT, int glu_perm, LAS float* scr, int item, int lane, const float* colscale = nullptr) {
    const int nblk = N / 32, kb = item / nblk, nb = item % nblk, k0 = 64 * kb, n0 = 32 * nb;
    int r0 = n0;
    if (glu_perm && n0 < 2048) { const int half = n0 >> 10, ch = n0 & 1023; r0 = (ch >> 7) * 256 + half * 128 + (ch & 127); }
    const int lr = lane >> 3, c4 = (lane & 7) * 4;
    f32x4 v[8];
#pragma unroll
    for (int i = 0; i < 8; ++i) v[i] = *(const f32x4*)(W + (size_t)(k0 + lr + 8 * i) * N + n0 + c4);
    const f32x4 csc = colscale ? *(const f32x4*)(colscale + n0 + c4) : (f32x4){1.f, 1.f, 1.f, 1.f};
#pragma unroll
    for (int i = 0; i < 8; ++i) { LAS float* d = scr + (lr + 8 * i) * 33 + c4; const f32x4 w = v[i] * csc; d[0] = w.x; d[1] = w.y; d[2] = w.z; d[3] = w.w; }
    asm volatile("s_waitcnt lgkmcnt(0)" ::: "memory");
    const int c = lane & 7;
#pragma unroll
    for (int j = 0; j < 4; ++j) { const int n = (lane >> 3) + 8 * j; const LAS float* sp = scr + (8 * c) * 33 + n;
        u32x4 o; o.x = cvt_pk_bf16(sp[0 * 33], sp[1 * 33]); o.y = cvt_pk_bf16(sp[2 * 33], sp[3 * 33]); o.z = cvt_pk_bf16(sp[4 * 33], sp[5 * 33]); o.w = cvt_pk_bf16(sp[6 * 33], sp[7 * 33]);
        *(u32x4*)(WT + (size_t)(r0 + n) * K + k0 + 8 * c) = o; }
    asm volatile("s_waitcnt lgkmcnt(0)" ::: "memory");
}

__device__ __forceinline__ void norm_mod_row(const float* xrow, const float* sh, const float* sc, bf16_t* orow, int lane) {
    const f32x4* xr = (const f32x4*)xrow + lane; f32x4 v[8]; float s = 0.f;
#pragma unroll
    for (int j = 0; j < 8; ++j) { v[j] = xr[64 * j]; s += (v[j].x * v[j].x + v[j].y * v[j].y) + (v[j].z * v[j].z + v[j].w * v[j].w); }
    const float rstd = 1.0f / sqrtf(wave_sum(s) * (1.f / DM) + EPS);
    u32x2* o8 = (u32x2*)orow + lane;
#pragma unroll
    for (int j = 0; j < 8; ++j) { const f32x4 a = ((const f32x4*)sc)[lane + 64 * j], b = ((const f32x4*)sh)[lane + 64 * j]; const f32x4 y = v[j] * rstd * (a + 1.0f) + b;
        u32x2 w; w.x = cvt_pk_bf16(y.x, y.y); w.y = cvt_pk_bf16(y.z, y.w); o8[64 * j] = w; }
}

template <int W> __device__ __forceinline__ void pool_chunk(const float* U, bf16_t* Dd, int row0, int seq_lo, int seq_hi, int ch) {
    f32x2 in[W + 7];
#pragma unroll
    for (int i = 0; i < W + 7; ++i) { const int r = row0 - W / 2 + i; const bool ok = (r >= seq_lo) && (r < seq_hi);
        in[i] = ok ? *(const f32x2*)(U + (size_t)r * 1024 + ch) : (f32x2){0.f, 0.f}; }
#pragma unroll
    for (int o = 0; o < 8; ++o) { f32x2 s = {0.f, 0.f};
#pragma unroll
        for (int j = 0; j < W; ++j) s += in[o + j];
        const int t = row0 + o; const int lo = max(t - W / 2, seq_lo), hi = min(t - W / 2 + W, seq_hi); const float inv = 1.0f / (float)(hi - lo);
        const f32x2 d = s * inv - in[o + W / 2];
        *(unsigned*)(Dd + (size_t)t * 1024 + ch) = cvt_pk_bf16(d.x, d.y); }
}

struct Params { const float* in[25]; float* out; unsigned char* ws; };

__global__ void __launch_bounds__(512, 2) fwd_mega(Params p) {
    extern __shared__ __attribute__((aligned(16))) unsigned char lds_raw[];
    cg::grid_group grid = cg::this_grid();
    LAS unsigned char* lds = (LAS unsigned char*)lds_raw;
    const int G = gridDim.x, bx = blockIdx.x;
#define PHASE_BEGIN() int tid = threadIdx.x; asm volatile("" : "+v"(tid)); size_t wz_ = 0; asm volatile("" : "+s"(wz_)); unsigned char* ws = p.ws + wz_; \
    const int lane = tid & 63, wave = __builtin_amdgcn_readfirstlane(tid >> 6); const int gw = bx * 8 + wave, NGW = G * 8; (void)lane; (void)gw; (void)NGW; \
    float* MODS = (float*)(ws + WS_MODS); (void)MODS
#define DEFP(T, name, off) T* name = (T*)(ws + (off))
    volatile LAS unsigned* MISC = (volatile LAS unsigned*)(lds + 131072 + 320);
    if (threadIdx.x < 32) MISC[threadIdx.x] = 0u;
    __syncthreads();
    const XcdBarrier xbar = xcd_barrier_post((unsigned*)(p.ws + WS_BAR), MISC + 8);
#define GRID_BAR() xcd_barrier(xbar)
#define MOD(l, cnd, chunk) (MODS + ((l) * 2 + (cnd)) * NMODV + (chunk) * DM)

    {
        PHASE_BEGIN();
        LAS float* sS = (LAS float*)lds;
        LAS float* red = (LAS float*)(lds + 16384);
        for (int k = tid; k < DM; k += 512) { const float a = p.in[1][k], b = p.in[3][k]; sS[k] = a / (1.0f + expf(-a)); sS[DM + k] = b / (1.0f + expf(-b)); }
        __syncthreads();
        const int cgi = tid & 7, ks = tid >> 3;
        for (int item = bx; item < 768; item += G) {
            const int l = item / 384, col0 = (item % 384) * 32;
            const float* Wa = l ? p.in[16] : p.in[4]; const float* bvec = l ? p.in[17] : p.in[5];
            f32x4 a0 = {0.f, 0.f, 0.f, 0.f}, a1 = {0.f, 0.f, 0.f, 0.f};
            const float* wp = Wa + (size_t)(ks * 32) * NMODV + col0 + cgi * 4;
#pragma unroll 8
            for (int kk = 0; kk < 32; ++kk) { const f32x4 w = *(const f32x4*)(wp + (size_t)kk * NMODV); const float s0 = sS[ks * 32 + kk], s1 = sS[DM + ks * 32 + kk]; a0 += w * s0; a1 += w * s1; }
            *(LAS f32x4*)(red + (ks * 8 + cgi) * 8) = a0; *(LAS f32x4*)(red + (ks * 8 + cgi) * 8 + 4) = a1;
            __syncthreads();
            if (tid < 64) { float s = 0.f;
#pragma unroll 8
                for (int q = 0; q < 64; ++q) s += red[q * 64 + tid];
                const int cnd = (tid >> 2) & 1, colj = (tid >> 3) * 4 + (tid & 3);
                MODS[(l * 2 + cnd) * NMODV + col0 + colj] = s + bvec[col0 + colj]; }
            __syncthreads();
        }
        __syncthreads();
        LAS float* scr = (LAS float*)(lds + wave * 16384);
        constexpr int I_IN = 32 * 96, I_OUT = 32 * 64, I_UP = 32 * 256, I_DN = 128 * 64, I_PW = 4 * 8;
        constexpr int NITEMS = 2 * (I_IN + I_OUT + I_UP + I_DN) + 4 * I_PW;
        for (int it = gw; it < NITEMS; it += NGW) {
            int r = it;
            if (r < I_IN) { transpose_item(p.in[6], DM, DIN, (bf16_t*)(ws + WS_WIN0), 1, scr, r, lane); continue; } r -= I_IN;
            if (r < I_OUT) { transpose_item(p.in[13], DM, DM, (bf16_t*)(ws + WS_WOUT0), 0, scr, r, lane); continue; } r -= I_OUT;
            if (r < I_UP) { transpose_item(p.in[14], DM, DFF, (bf16_t*)(ws + WS_WUP0), 0, scr, r, lane); continue; } r -= I_UP;
            if (r < I_DN) { transpose_item(p.in[15], DFF, DM, (bf16_t*)(ws + WS_WDN0), 0, scr, r, lane); continue; } r -= I_DN;
            if (r < I_IN) { transpose_item(p.in[18], DM, DIN, (bf16_t*)(ws + WS_WQKV1), 0, scr, r, lane); continue; } r -= I_IN;
            if (r < I_OUT) { transpose_item(p.in[21], DM, DM, (bf16_t*)(ws + WS_WOUT1), 0, scr, r, lane); continue; } r -= I_OUT;
            if (r < I_UP) { transpose_item(p.in[22], DM, DFF, (bf16_t*)(ws + WS_WUP1), 0, scr, r, lane); continue; } r -= I_UP;
            if (r < I_DN) { transpose_item(p.in[23], DFF, DM, (bf16_t*)(ws + WS_WDN1), 0, scr, r, lane); continue; } r -= I_DN;
            { const int gidx = r / I_PW; transpose_item(p.in[11] + (size_t)gidx * 65536, 256, 256, (bf16_t*)(ws + WS_WPOOL) + (size_t)gidx * 65536, 0, scr, r % I_PW, lane, p.in[12] + gidx * 256); }
        }
    }
    grid.sync();

    {
        PHASE_BEGIN(); DEFP(bf16_t, XN, WS_XN);
        for (int row = gw; row < MT; row += NGW) {
            const bool isc = row >= SEQ;
            norm_mod_row(isc ? p.in[2] + (size_t)(row - SEQ) * DM : p.in[0] + (size_t)row * DM, MOD(0, isc ? 1 : 0, 0), MOD(0, isc ? 1 : 0, 1), XN + (size_t)row * DM, lane);
        }
    }
    GRID_BAR();

    {
        PHASE_BEGIN(); DEFP(bf16_t, XN, WS_XN); DEFP(bf16_t, W_IN0, WS_WIN0); DEFP(float, GLU, WS_GLU); DEFP(float, U, WS_U);
        pg8::Gemm g{XN, W_IN0, MT, DIN, DM, DM, DM, 0}; pg8::StaticOrder S; S.init(MT, DIN, G, bx);
        pg8::EpiGlu E{GLU, U};
        pg8::gemm_phase<pg8::EpiGlu, true, true>(lds, g, S, E, tid);
    }
    GRID_BAR();

    {
        PHASE_BEGIN(); DEFP(float, GLU, WS_GLU); DEFP(float, U, WS_U); DEFP(bf16_t, YC, WS_YC); DEFP(bf16_t, Dd, WS_D);
        const int ch = 2 * tid;
        f32x2 cw[31];
#pragma unroll
        for (int j = 0; j < 31; ++j) cw[j] = *(const f32x2*)(p.in[7] + j * 1024 + ch);
        const f32x2 cb = *(const f32x2*)(p.in[8] + ch), lg = *(const f32x2*)(p.in[9] + ch), lb = *(const f32x2*)(p.in[10] + ch);
        LAS float* red1 = (LAS float*)lds; LAS float* red2 = (LAS float*)(lds + 256);
        for (int chunk = bx; chunk < MT / 8; chunk += G) {
            const int row0 = chunk * 8; const int seq_lo = row0 < SEQ ? 0 : SEQ, seq_hi = row0 < SEQ ? SEQ : MT;
            f32x2 acc[8];
#pragma unroll
            for (int o = 0; o < 8; ++o) acc[o] = cb;
#pragma unroll
            for (int i = 0; i < 38; ++i) { const int r = row0 - 15 + i; const bool ok = (r >= seq_lo) && (r < seq_hi);
                const f32x2 xv = ok ? *(const f32x2*)(GLU + (size_t)r * 1024 + ch) : (f32x2){0.f, 0.f};
#pragma unroll
                for (int o = 0; o < 8; ++o) { const int j = i - o; if (j >= 0 && j < 31) acc[o] += xv * cw[j]; } }
            float s[8];
#pragma unroll
            for (int o = 0; o < 8; ++o) s[o] = wave_sum(acc[o].x + acc[o].y);
            if (lane == 0) {
#pragma unroll
                for (int o = 0; o < 8; ++o) red1[wave * 8 + o] = s[o]; }
            __syncthreads();
#pragma unroll
            for (int o = 0; o < 8; ++o) { float t = 0.f;
#pragma unroll
                for (int w = 0; w < 8; ++w) t += red1[w * 8 + o];
                const float mean = t * (1.f / 1024.f); acc[o] = acc[o] - mean; s[o] = wave_sum(acc[o].x * acc[o].x + acc[o].y * acc[o].y); }
            if (lane == 0) {
#pragma unroll
                for (int o = 0; o < 8; ++o) red2[wave * 8 + o] = s[o]; }
            __syncthreads();
#pragma unroll
            for (int o = 0; o < 8; ++o) { float t = 0.f;
#pragma unroll
                for (int w = 0; w < 8; ++w) t += red2[w * 8 + o];
                const float rstd = 1.0f / sqrtf(t * (1.f / 1024.f) + EPS);
                const f32x2 y = acc[o] * rstd * lg + lb;
                const float y0 = y.x * sigmoidf_(y.x), y1 = y.y * sigmoidf_(y.y);
                *(unsigned*)(YC + (size_t)(row0 + o) * DM + ch) = cvt_pk_bf16(y0, y1); }
            const int pg = wave >> 1;
            if (pg == 0) pool_chunk<2>(U, Dd, row0, seq_lo, seq_hi, ch);
            else if (pg == 1) pool_chunk<4>(U, Dd, row0, seq_lo, seq_hi, ch);
            else if (pg == 2) pool_chunk<8>(U, Dd, row0, seq_lo, seq_hi, ch);
            else pool_chunk<16>(U, Dd, row0, seq_lo, seq_hi, ch);
        }
    }
    GRID_BAR();

    {
        PHASE_BEGIN(); DEFP(bf16_t, Dd, WS_D); DEFP(bf16_t, W_POOL, WS_WPOOL); DEFP(bf16_t, YC, WS_YC);
        pg8::Gemm g{Dd, W_POOL, MT, 1024, 256, 1024, 256, 256}; pg8::StaticOrder S; S.init(MT, 1024, G, bx);
        pg8::EpiBf16<0, false> E{YC, DM, 1024, nullptr};
        pg8::gemm_phase<pg8::EpiBf16<0, false>, true, true>(lds, g, S, E, tid);
    }
    GRID_BAR();

    {
        PHASE_BEGIN(); DEFP(bf16_t, YC, WS_YC); DEFP(bf16_t, W_OUT0, WS_WOUT0); DEFP(float, XR, WS_XR);
        pg8::Gemm g{YC, W_OUT0, MT, DM, DM, DM, DM, 0}; pg8::StaticOrder S; S.init(MT, DM, G, bx);
        pg8::EpiRes E{p.in[0], p.in[2], MOD(0, 0, 2), MOD(0, 1, 2), XR};
        pg8::gemm_phase<pg8::EpiRes, true, true>(lds, g, S, E, tid);
    }
    GRID_BAR();

    {
        PHASE_BEGIN(); DEFP(bf16_t, XN, WS_XN); DEFP(float, XR, WS_XR);
        for (int row = gw; row < MT; row += NGW) {
            const int cnd = row >= SEQ ? 1 : 0;
            norm_mod_row(XR + (size_t)row * DM, MOD(0, cnd, 3), MOD(0, cnd, 4), XN + (size_t)row * DM, lane);
        }
    }
    GRID_BAR();

    {
        PHASE_BEGIN(); DEFP(bf16_t, XN, WS_XN); DEFP(bf16_t, W_UP0, WS_WUP0); DEFP(bf16_t, H, WS_R);
        pg8::Gemm g{XN, W_UP0, MT, DFF, DM, DM, DM, 0}; pg8::StaticOrder S; S.init(MT, DFF, G, bx);
        pg8::EpiBf16<1, false> E{H, DFF, 0, nullptr};
        pg8::gemm_phase<pg8::EpiBf16<1, false>, true, true>(lds, g, S, E, tid);
    }
    GRID_BAR();

    {
        PHASE_BEGIN(); DEFP(bf16_t, H, WS_R); DEFP(bf16_t, W_DN0, WS_WDN0); DEFP(float, XR, WS_XR);
        pg8::Gemm g{H, W_DN0, MT, DM, DFF, DFF, DFF, 0}; pg8::StaticOrder S; S.init(MT, DM, G, bx);
        pg8::EpiRes E{XR, XR + (size_t)SEQ * DM, MOD(0, 0, 5), MOD(0, 1, 5), XR};
        pg8::gemm_phase<pg8::EpiRes, true, true>(lds, g, S, E, tid);
    }
    GRID_BAR();

    {
        PHASE_BEGIN(); DEFP(bf16_t, XN, WS_XN); DEFP(float, XR, WS_XR);
        for (int row = gw; row < MT; row += NGW) {
            const int cnd = row >= SEQ ? 1 : 0;
            norm_mod_row(XR + (size_t)row * DM, MOD(1, cnd, 0), MOD(1, cnd, 1), XN + (size_t)row * DM, lane);
        }
    }
    GRID_BAR();

    {
        PHASE_BEGIN(); DEFP(bf16_t, XN, WS_XN); DEFP(bf16_t, W_QKV1, WS_WQKV1); DEFP(float, QKVRAW, WS_QKVRAW);
        pg8::Gemm g{XN, W_QKV1, MT, DIN, DM, DM, DM, 0}; pg8::StaticOrder S; S.init(MT, DIN, G, bx);
        pg8::EpiF32 E{QKVRAW, DIN};
        pg8::gemm_phase<pg8::EpiF32, true, true>(lds, g, S, E, tid);
    }
    GRID_BAR();

    {
        PHASE_BEGIN(); DEFP(float, QKVRAW, WS_QKVRAW); DEFP(bf16_t, Qb, WS_Q); DEFP(bf16_t, Kb, WS_K); DEFP(bf16_t, Vb, WS_V);
        const int l31 = lane & 31, hsel = lane >> 5, d0 = 4 * l31, axis = l31 >> 4; const bool second = (l31 & 8) != 0;
        float freq[4];
#pragma unroll
        for (int c = 0; c < 4; ++c) freq[c] = exp2f(-(float)(((d0 & 31) + c)) * (13.287712379549449f / 32.0f));
        const f32x4 qg = *(const f32x4*)(p.in[19] + d0), kg = *(const f32x4*)(p.in[20] + d0);
        for (int row = gw; row < MT; row += NGW) {
            const bool isc = row >= SEQ; const f32x4* src = (const f32x4*)(QKVRAW + (size_t)row * DIN) + lane;
            f32x4 v[12];
#pragma unroll
            for (int j = 0; j < 12; ++j) v[j] = src[64 * j];
            f32x4 cs = {1.f, 1.f, 1.f, 1.f}, sn = {0.f, 0.f, 0.f, 0.f};
            if (!isc) { const float pos = (float)(axis == 0 ? (row >> 6) : (row & 63));
#pragma unroll
                for (int c = 0; c < 4; ++c) { const float ang = pos * freq[c]; cs[c] = cosf(ang); sn[c] = sinf(ang); } }
            const int krow = isc ? row - SEQ : CTX + row;
#pragma unroll
            for (int j = 0; j < 10; ++j) {
                if (j < 8 && isc) continue;
                float ss = (v[j].x * v[j].x + v[j].y * v[j].y) + (v[j].z * v[j].z + v[j].w * v[j].w);
#pragma unroll
                for (int o = 1; o < 32; o <<= 1) ss += __shfl_xor(ss, o);
                const float rstd = 1.0f / sqrtf(ss * (1.f / 128.f) + EPS);
                const f32x4 y = v[j] * rstd * (j < 8 ? qg : kg);
                f32x4 pr; pr.x = __shfl_xor(y.x, 8); pr.y = __shfl_xor(y.y, 8); pr.z = __shfl_xor(y.z, 8); pr.w = __shfl_xor(y.w, 8);
                const f32x4 o4 = second ? (pr * sn + y * cs) : (y * cs - pr * sn);
                u32x2 w; w.x = cvt_pk_bf16(o4.x, o4.y); w.y = cvt_pk_bf16(o4.z, o4.w);
                if (j < 8) *(u32x2*)(Qb + (size_t)row * DM + (2 * j + hsel) * 128 + d0) = w;
                else *(u32x2*)(Kb + (size_t)krow * 512 + (2 * (j - 8) + hsel) * 128 + d0) = w;
            }
#pragma unroll
            for (int j = 10; j < 12; ++j) { u32x2 w; w.x = cvt_pk_bf16(v[j].x, v[j].y); w.y = cvt_pk_bf16(v[j].z, v[j].w);
                *(u32x2*)(Vb + (size_t)krow * 512 + (2 * (j - 10) + hsel) * 128 + d0) = w; }
        }
    }
    GRID_BAR();

    {
        PHASE_BEGIN(); DEFP(bf16_t, Qb, WS_Q); DEFP(bf16_t, Kb, WS_K); DEFP(bf16_t, Vb, WS_V); DEFP(bf16_t, Ob, WS_O);
        const int vcu = (G % 8 == 0) ? (bx % 8) * (G / 8) + bx / 8 : bx;
        for (int uidx = vcu; uidx < 16 * 32; uidx += G) {
            const int h = uidx >> 5, qb = uidx & 31, kvh = h >> 2;
            att::attn_dense_body((const att::bf16*)Qb + (size_t)qb * 256 * DM + h * 128, (const att::bf16*)Kb + kvh * 128, (const att::bf16*)Vb + kvh * 128,
                                 (att::bf16*)Ob + (size_t)qb * 256 * DM + h * 128, MT, (char*)lds_raw, tid);
        }
    }
    GRID_BAR();

    {
        PHASE_BEGIN(); DEFP(bf16_t, Ob, WS_O); DEFP(bf16_t, W_OUT1, WS_WOUT1); DEFP(float, XR, WS_XR);
        pg8::Gemm g{Ob, W_OUT1, SEQ, DM, DM, DM, DM, 0}; pg8::StaticOrder S; S.init(SEQ, DM, G, bx);
        pg8::EpiRes E{XR, XR, MOD(1, 0, 2), MOD(1, 0, 2), XR};
        pg8::gemm_phase<pg8::EpiRes, true, true>(lds, g, S, E, tid);
    }
    GRID_BAR();

    {
        PHASE_BEGIN(); DEFP(bf16_t, XN, WS_XN); DEFP(float, XR, WS_XR);
        for (int row = gw; row < SEQ; row += NGW) norm_mod_row(XR + (size_t)row * DM, MOD(1, 0, 3), MOD(1, 0, 4), XN + (size_t)row * DM, lane);
    }
    GRID_BAR();

    {
        PHASE_BEGIN(); DEFP(bf16_t, XN, WS_XN); DEFP(bf16_t, W_UP1, WS_WUP1); DEFP(bf16_t, H, WS_R);
        pg8::Gemm g{XN, W_UP1, SEQ, DFF, DM, DM, DM, 0}; pg8::StaticOrder S; S.init(SEQ, DFF, G, bx);
        pg8::EpiBf16<1, false> E{H, DFF, 0, nullptr};
        pg8::gemm_phase<pg8::EpiBf16<1, false>, true, true>(lds, g, S, E, tid);
    }
    GRID_BAR();

    {
        PHASE_BEGIN(); DEFP(bf16_t, H, WS_R); DEFP(bf16_t, W_DN1, WS_WDN1); DEFP(float, XR, WS_XR);
        pg8::Gemm g{H, W_DN1, SEQ, DM, DFF, DFF, DFF, 0}; pg8::StaticOrder S; S.init(SEQ, DM, G, bx);
        pg8::EpiRes E{XR, XR, MOD(1, 0, 5), MOD(1, 0, 5), XR};
        pg8::gemm_phase<pg8::EpiRes, true, true>(lds, g, S, E, tid);
    }
    GRID_BAR();

    {
        PHASE_BEGIN(); DEFP(float, XR, WS_XR);
        for (int row = gw; row < SEQ; row += NGW) {
            const f32x4* xr = (const f32x4*)(XR + (size_t)row * DM) + lane; f32x4 v[8]; float s = 0.f;
#pragma unroll
            for (int j = 0; j < 8; ++j) { v[j] = xr[64 * j]; s += (v[j].x * v[j].x + v[j].y * v[j].y) + (v[j].z * v[j].z + v[j].w * v[j].w); }
            const float rstd = 1.0f / sqrtf(wave_sum(s) * (1.f / DM) + EPS);
            f32x4* o = (f32x4*)(p.out + (size_t)row * DM) + lane;
#pragma unroll
            for (int j = 0; j < 8; ++j) o[64 * j] = v[j] * rstd * ((const f32x4*)p.in[24])[lane + 64 * j];
        }
    }
#undef MOD
#undef GRID_BAR
}

extern "C" void kernel_launch(void* const* d_in, const int* in_sizes, int n_in, void* d_out, int out_size, void* d_ws, size_t ws_size, hipStream_t stream) {
    static int grid = 0;
    if (grid == 0) {
        if (n_in != 25 || ws_size < WS_END) { fprintf(stderr, "kernel_launch: n_in %d ws %zu (need 25, >= %zu)\n", n_in, ws_size, (size_t)WS_END); }
        int dev = 0, cus = 0, per_cu = 0;
        hipGetDevice(&dev);
        hipDeviceGetAttribute(&cus, hipDeviceAttributeMultiprocessorCount, dev);
        hipFuncSetAttribute((const void*)fwd_mega, hipFuncAttributeMaxDynamicSharedMemorySize, LDS_BYTES);
        hipOccupancyMaxActiveBlocksPerMultiprocessor(&per_cu, (const void*)fwd_mega, 512, LDS_BYTES);
        (void)hipGetLastError();
        if (per_cu < 1) { fprintf(stderr, "kernel_launch: occupancy query says %d blocks per CU\n", per_cu); per_cu = 1; }
        grid = cus;
    }
    (void)hipMemsetAsync(d_ws, 0, WS_CTL_BYTES, stream);
    Params p{};
    for (int i = 0; i < 25; ++i) p.in[i] = (const float*)d_in[i];
    p.out = (float*)d_out; p.ws = (unsigned char*)d_ws;
    void* args[] = {&p};
    hipError_t e = hipLaunchCooperativeKernel((const void*)fwd_mega, dim3(grid), dim3(512), args, LDS_BYTES, stream);
    if (e != hipSuccess) fprintf(stderr, "cooperative launch failed: %s (grid %d)\n", hipGetErrorString(e), grid);
}
```

```cpp
#include <hip/hip_runtime.h>
#include <hip/hip_cooperative_groups.h>
#include <hip/hip_bf16.h>
#include <cstdio>
#include <cstdint>
namespace cg = cooperative_groups;

#define LAS __attribute__((address_space(3)))
typedef unsigned short bf16_t;
typedef short bf16x8 __attribute__((ext_vector_type(8)));
typedef short s16x4 __attribute__((ext_vector_type(4)));
typedef float f32x4 __attribute__((ext_vector_type(4)));
typedef float f32x2 __attribute__((ext_vector_type(2)));
typedef float f32x16 __attribute__((ext_vector_type(16)));
typedef unsigned u32x4 __attribute__((ext_vector_type(4)));
typedef unsigned u32x2 __attribute__((ext_vector_type(2)));

constexpr int DM = 2048, SEQ = 8192, CTX = 256, MT = SEQ + CTX  , DFF = 8192, DIN = 3072;
constexpr int NMODV = 6 * DM;
constexpr float EPS = 1e-6f;

constexpr size_t MiB = 1u << 20;
constexpr size_t WS_BAR = 65536, WS_CTL_BYTES = 262144;
constexpr size_t WS_MODS = 1 * MiB;
constexpr size_t WS_WIN0 = 2 * MiB, WS_WOUT0 = 14 * MiB, WS_WUP0 = 22 * MiB, WS_WDN0 = 54 * MiB;
constexpr size_t WS_WQKV1 = 86 * MiB, WS_WOUT1 = 98 * MiB, WS_WUP1 = 106 * MiB, WS_WDN1 = 138 * MiB, WS_WPOOL = 170 * MiB;
constexpr size_t WS_XR = 172 * MiB;
constexpr size_t WS_XN = 238 * MiB;
constexpr size_t WS_R = 272 * MiB;
constexpr size_t WS_GLU = WS_R, WS_U = WS_R + 33 * MiB, WS_YC = WS_R + 66 * MiB, WS_D = WS_R + 99 * MiB;
constexpr size_t WS_Q = WS_R, WS_K = WS_R + 32 * MiB, WS_V = WS_R + 41 * MiB, WS_O = WS_R + 50 * MiB;
constexpr size_t WS_QKVRAW = 404 * MiB;
constexpr size_t WS_PART = WS_QKVRAW;
constexpr size_t WS_END = 504 * MiB;
constexpr int S_OUT0 = 8, S_DN0 = 16;

constexpr int LDS_BYTES = 147456;

__device__ __forceinline__ unsigned cvt_pk_bf16(float lo, float hi) { unsigned r; asm volatile("v_cvt_pk_bf16_f32 %0, %1, %2" : "=v"(r) : "v"(lo), "v"(hi)); return r; }
__device__ __forceinline__ float wave_sum(float v) {
#pragma unroll
    for (int o = 1; o < 64; o <<= 1) v += __shfl_xor(v, o);
    return v;
}
__device__ __forceinline__ float sigmoidf_(float g) { return 1.0f / (1.0f + __expf(-g)); }

namespace pg8 {
constexpr int BM = 256, BK = 64, HALF = 128, HTB = HALF * BK * 2, STAGE_BYTES = 8 * HTB, NXCD = 8, WGM = 8;
__host__ __device__ __forceinline__ int lds_byte(int r, int c) { const int st = (r >> 4) * 2 + (c >> 5), rr = r & 15, cc = c & 31, ob = rr * 64 + cc * 2; return st * 1024 + (ob ^ (((ob >> 9) & 1) << 5)); }
__host__ __device__ __forceinline__ void stage_rc(int b, int& R, int& C) { const int st = b / 1024, sb = b % 1024, swz = sb ^ (((sb >> 9) & 1) << 5); R = (st >> 1) * 16 + swz / 64; C = (st & 1) * 32 + (swz % 64) / 2; }
__host__ __device__ __forceinline__ int perm32(int rho) { const int n = rho >> 4, i = rho & 15; return 8 * (i >> 2) + 4 * n + (i & 3); }

struct Unit { int pm, pn, koff, nt, sub; };
struct Gemm { const bf16_t* A; const bf16_t* Bt; int M, N, K, lda, ldb, a_pn_off; };

struct StaticOrder {
    int nM, nN, nwg, G, c, ntFull;
    __host__ __device__ void init(int M, int N, int K, int G_, int c_) { nM = M / BM; nN = N / BM; nwg = nM * nN; G = G_; c = c_; ntFull = K / BK; }
    __device__ __forceinline__ void tile(int L, int& pm, int& pn) const {
        int wgid = L; { const int q = nwg / NXCD, r = nwg % NXCD, xcd = wgid % NXCD, off = wgid / NXCD; wgid = (xcd < r ? xcd * (q + 1) : r * (q + 1) + (xcd - r) * q) + off; }
        const int nig = WGM * nN, gid = wgid / nig, fm = gid * WGM, gsz = (nM - fm) < WGM ? (nM - fm) : WGM;
        pm = fm + ((wgid % nig) % gsz); pn = (wgid % nig) / gsz;
    }
    __device__ __forceinline__ bool next(int i, Unit& u) const {
        const int L = i * G + c; const bool ok = L < nwg; int pm, pn; tile(ok ? L : 0, pm, pn);
        u.pm = pm; u.pn = pn; u.koff = 0; u.nt = ntFull; u.sub = -1; return ok;
    }
};
struct SplitOrder {
    StaticOrder main; int nMine, pmSub, S, ntSub, nSub;
    __host__ __device__ void init(int M, int N, int K, int G_, int c_, int pmSub_, int S_) { main.init(M, N, K, G_, c_); nMine = c_ < main.nwg ? (main.nwg - c_ + G_ - 1) / G_ : 0; pmSub = pmSub_; S = S_; ntSub = K / BK / S_; nSub = (N / BM) * S_; }
    __device__ __forceinline__ bool next(int i, Unit& u) const {
        const bool ismain = i < nMine;
        int pm, pn; main.tile(ismain ? i * main.G + main.c : 0, pm, pn);
        const int j = (i - nMine) * main.G + main.c; const int sl = j % S;
        u.pm = ismain ? pm : pmSub; u.pn = ismain ? pn : j / S; u.koff = ismain ? 0 : sl * ntSub * BK; u.nt = ismain ? main.ntFull : ntSub; u.sub = ismain ? -1 : sl;
        return ismain || j < nSub;
    }
};

typedef f32x4 Acc[2][2][4][2];

template <int ACT, bool HAS_SCALE> struct EpiBf16 {
    static constexpr bool PERM = true;
    bf16_t* O; int ldc; int col_off; const float* scale;
    __device__ __forceinline__ void operator()(const Acc& acc, const Unit& u, int wr, int wc, int fr, int fq) const {
        const int row0 = u.pm * BM + wr * 64 + fr; const int col0 = u.pn * BM + wc * 32 + 8 * fq;
        f32x4 sv[2][2];
        if constexpr (HAS_SCALE) {
#pragma unroll
        for (int bj = 0; bj < 2; ++bj)
#pragma unroll
            for (int n = 0; n < 2; ++n) sv[bj][n] = *(const f32x4*)(scale + col0 + bj * HALF + 4 * n);
        }
#pragma unroll
        for (int ai = 0; ai < 2; ++ai)
#pragma unroll
            for (int m = 0; m < 4; ++m) { bf16_t* rowp = O + (size_t)(row0 + ai * HALF + m * 16) * ldc + col_off + col0;
#pragma unroll
                for (int bj = 0; bj < 2; ++bj) { f32x4 v0 = acc[ai][bj][m][0], v1 = acc[ai][bj][m][1];
                    if (ACT == 1) { v0 = __builtin_elementwise_max(v0, (f32x4){0.f, 0.f, 0.f, 0.f}); v1 = __builtin_elementwise_max(v1, (f32x4){0.f, 0.f, 0.f, 0.f}); v0 = v0 * v0; v1 = v1 * v1; }
                    if constexpr (HAS_SCALE) { v0 = v0 * sv[bj][0]; v1 = v1 * sv[bj][1]; }
                    u32x4 w; w.x = cvt_pk_bf16(v0[0], v0[1]); w.y = cvt_pk_bf16(v0[2], v0[3]); w.z = cvt_pk_bf16(v1[0], v1[1]); w.w = cvt_pk_bf16(v1[2], v1[3]);
                    *(u32x4*)(rowp + bj * HALF) = w; } }
    }
};
struct EpiF32 {
    static constexpr bool PERM = false;
    float* O; int ldc;
    __device__ __forceinline__ void operator()(const Acc& acc, const Unit& u, int wr, int wc, int fr, int fq) const {
        const int row0 = u.pm * BM + wr * 64 + fr; const int col0 = u.pn * BM + wc * 32 + 4 * fq;
#pragma unroll
        for (int ai = 0; ai < 2; ++ai)
#pragma unroll
            for (int m = 0; m < 4; ++m) { float* rowp = O + (size_t)(row0 + ai * HALF + m * 16) * ldc + col0;
#pragma unroll
                for (int bj = 0; bj < 2; ++bj)
#pragma unroll
                    for (int n = 0; n < 2; ++n) *(f32x4*)(rowp + bj * HALF + n * 16) = acc[ai][bj][m][n]; }
    }
};
struct EpiGlu {
    static constexpr bool PERM = false;
    float* GLU; float* U;
    __device__ __forceinline__ void operator()(const Acc& acc, const Unit& u, int wr, int wc, int fr, int fq) const {
        const int row0 = u.pm * BM + wr * 64 + fr;
        if (u.pn < 8) {
            const int col0 = u.pn * 128 + wc * 32 + 4 * fq;
#pragma unroll
            for (int ai = 0; ai < 2; ++ai)
#pragma unroll
                for (int m = 0; m < 4; ++m) { float* rowp = GLU + (size_t)(row0 + ai * HALF + m * 16) * 1024 + col0;
#pragma unroll
                    for (int n = 0; n < 2; ++n) { const f32x4 a = acc[ai][0][m][n], g = acc[ai][1][m][n]; f32x4 o;
                        o[0] = a[0] * sigmoidf_(g[0]); o[1] = a[1] * sigmoidf_(g[1]); o[2] = a[2] * sigmoidf_(g[2]); o[3] = a[3] * sigmoidf_(g[3]);
                        *(f32x4*)(rowp + n * 16) = o; } }
        } else {
            const int col0 = (u.pn - 8) * BM + wc * 32 + 4 * fq;
#pragma unroll
            for (int ai = 0; ai < 2; ++ai)
#pragma unroll
                for (int m = 0; m < 4; ++m) { float* rowp = U + (size_t)(row0 + ai * HALF + m * 16) * 1024 + col0;
#pragma unroll
                    for (int bj = 0; bj < 2; ++bj)
#pragma unroll
                        for (int n = 0; n < 2; ++n) *(f32x4*)(rowp + bj * HALF + n * 16) = acc[ai][bj][m][n]; }
        }
    }
};
struct EpiRes {
    static constexpr bool PERM = false;
    const float* baseL; const float* baseC; const float* gateL; const float* gateC; float* out;
    float* part;
    __device__ __forceinline__ void operator()(const Acc& acc, const Unit& u, int wr, int wc, int fr, int fq) const {
        if (u.sub >= 0) {
            float* pp = part + ((size_t)u.sub * BM + wr * 64 + fr) * DM + u.pn * BM + wc * 32 + 4 * fq;
#pragma unroll
            for (int ai = 0; ai < 2; ++ai)
#pragma unroll
                for (int m = 0; m < 4; ++m)
#pragma unroll
                    for (int bj = 0; bj < 2; ++bj)
#pragma unroll
                        for (int n = 0; n < 2; ++n) *(f32x4*)(pp + (size_t)(ai * HALF + m * 16) * DM + bj * HALF + n * 16) = acc[ai][bj][m][n];
            return;
        }
        const bool isc = u.pm >= 32;
        const int row0 = u.pm * BM + wr * 64 + fr; const int col0 = u.pn * BM + wc * 32 + 4 * fq;
        const float* gate = isc ? gateC : gateL;
        const float* base = isc ? baseC + (size_t)(row0 - SEQ) * DM : baseL + (size_t)row0 * DM;
        f32x4 gv[2][2];
#pragma unroll
        for (int bj = 0; bj < 2; ++bj)
#pragma unroll
            for (int n = 0; n < 2; ++n) gv[bj][n] = *(const f32x4*)(gate + col0 + bj * HALF + n * 16);
#pragma unroll
        for (int ai = 0; ai < 2; ++ai)
#pragma unroll
            for (int m = 0; m < 4; ++m) { const size_t ro = (size_t)(ai * HALF + m * 16) * DM + col0; float* op = out + (size_t)row0 * DM + ro;
#pragma unroll
                for (int bj = 0; bj < 2; ++bj)
#pragma unroll
                    for (int n = 0; n < 2; ++n) { const f32x4 b = *(const f32x4*)(base + ro + bj * HALF + n * 16);
                        *(f32x4*)(op + bj * HALF + n * 16) = b + gv[bj][n] * acc[ai][bj][m][n]; } }
    }
};

template <class Epi, class Sched, bool ALIGN_EPI, bool SP2>
__device__ __forceinline__ void gemm_phase(LAS unsigned char* lds, const Gemm g, const Sched& S, const Epi& E, const int tid) {
    const int wid = __builtin_amdgcn_readfirstlane(tid >> 6), lane = tid & 63, wr = wid >> 2, wc = wid & 3, fr = lane & 15, fq = lane >> 4;
    unsigned voffA[2], voffB[2];
#pragma unroll
    for (int i = 0; i < 2; ++i) { int R, C; stage_rc(tid * 16 + i * 8192, R, C); const int Rb = Epi::PERM ? ((R & ~31) + perm32(R & 31)) : R;
        voffA[i] = (unsigned)(R * g.lda + C) * 2u; voffB[i] = (unsigned)(Rb * g.ldb + C) * 2u; }
    const size_t kstep = (size_t)(BK * 2);
    const size_t hstepA = (size_t)HALF * g.lda * 2, hstepB = (size_t)HALF * g.ldb * 2;
    const unsigned ldsw = (unsigned)wid * 1024u;
    const int aoff = lds_byte(wr * 64 + fr, fq * 8), boff = lds_byte(wc * 32 + fr, fq * 8);
#define PG8_UA(u_) ((const char*)g.A + ((size_t)(u_).pm * BM * g.lda + (size_t)(u_).pn * g.a_pn_off + (u_).koff) * 2)
#define PG8_UB(u_) ((const char*)g.Bt + ((size_t)(u_).pn * BM * g.ldb + (u_).koff) * 2)
#define PG8_SA(b, h) (((b) * 2 + (h)) * HTB)
#define PG8_SB(b, h) ((4 + (b) * 2 + (h)) * HTB)
#define PG8_STAGE(bufoff, gbase, voff) do { _Pragma("unroll") for (int _i = 0; _i < 2; ++_i) \
        __builtin_amdgcn_global_load_lds((const unsigned*)((const char*)(gbase) + (voff)[_i]), (LAS unsigned*)(lds + (bufoff) + ldsw + _i * 8192), 16, 0, 0); } while (0)
#define PG8_LDA(dst, b, h) do { _Pragma("unroll") for (int m = 0; m < 4; ++m) _Pragma("unroll") for (int k = 0; k < 2; ++k) dst[m][k] = *(const LAS bf16x8*)(lds + PG8_SA(b, h) + aoff + m * 2048 + k * 1024); } while (0)
#define PG8_LDB(dst, b, h) do { _Pragma("unroll") for (int n = 0; n < 2; ++n) _Pragma("unroll") for (int k = 0; k < 2; ++k) dst[n][k] = *(const LAS bf16x8*)(lds + PG8_SB(b, h) + boff + n * 2048 + k * 1024); } while (0)
#define PG8_MMA(ai, bj, At, Bt) do { __builtin_amdgcn_s_setprio(1); _Pragma("unroll") for (int m = 0; m < 4; ++m) _Pragma("unroll") for (int n = 0; n < 2; ++n) _Pragma("unroll") for (int k = 0; k < 2; ++k) \
        acc[ai][bj][m][n] = __builtin_amdgcn_mfma_f32_16x16x32_bf16(Bt[n][k], At[m][k], acc[ai][bj][m][n], 0, 0, 0); __builtin_amdgcn_s_setprio(0); } while (0)
#define PG8_WAIT_V(n) asm volatile("s_waitcnt vmcnt(" #n ")" ::: "memory")
#define PG8_WAIT_L(n) asm volatile("s_waitcnt lgkmcnt(" #n ")" ::: "memory")
#define PG8_BAR __builtin_amdgcn_s_barrier()
#define PG8_SCHED __builtin_amdgcn_sched_barrier(0)
    Unit cur, nxt; int ui = 0;
    if (!S.next(0, cur)) return;
    f32x4 acc[2][2][4][2];
#pragma unroll
    for (int a = 0; a < 2; ++a)
#pragma unroll
        for (int b = 0; b < 2; ++b)
#pragma unroll
            for (int m = 0; m < 4; ++m)
#pragma unroll
                for (int n = 0; n < 2; ++n) acc[a][b][m][n] = (f32x4){0.f, 0.f, 0.f, 0.f};
    bf16x8 At[4][2], B0[2][2], B1[2][2];
    const char* cA = PG8_UA(cur); const char* cB = PG8_UB(cur);
    if constexpr (SP2) {
        PG8_STAGE(PG8_SB(0, 0), cB, voffB); PG8_STAGE(PG8_SB(0, 1), cB + hstepB, voffB); PG8_STAGE(PG8_SA(0, 0), cA, voffA); PG8_STAGE(PG8_SA(0, 1), cA + hstepA, voffA);
        if (wr == 1) PG8_BAR;
        PG8_WAIT_V(2); PG8_BAR;
        PG8_STAGE(PG8_SB(1, 0), cB + kstep, voffB); PG8_STAGE(PG8_SA(1, 0), cA + kstep, voffA); PG8_STAGE(PG8_SB(1, 1), cB + hstepB + kstep, voffB);
        PG8_WAIT_V(6); PG8_BAR;
    } else {
        PG8_STAGE(PG8_SB(0, 0), cB, voffB); PG8_STAGE(PG8_SA(0, 0), cA, voffA); PG8_STAGE(PG8_SB(0, 1), cB + hstepB, voffB); PG8_STAGE(PG8_SA(0, 1), cA + hstepA, voffA);
        if (wr == 1) PG8_BAR;
        PG8_WAIT_V(4); PG8_BAR;
        PG8_STAGE(PG8_SB(1, 0), cB + kstep, voffB); PG8_STAGE(PG8_SA(1, 0), cA + kstep, voffA); PG8_STAGE(PG8_SB(1, 1), cB + hstepB + kstep, voffB);
        PG8_WAIT_V(6); PG8_BAR;
    }
    for (;;) {
        const bool has_next = S.next(ui + 1, nxt);
        const char* nA = has_next ? PG8_UA(nxt) : cA; const char* nB = has_next ? PG8_UB(nxt) : cB;
        const int nt = cur.nt;
        for (int t = 0; t < nt; t += 2) {
            const bool last = (t == nt - 2);
            const char* a1 = cA + (size_t)(t + 1) * kstep;
            const char* a2 = last ? nA : cA + (size_t)(t + 2) * kstep; const char* b2 = last ? nB : cB + (size_t)(t + 2) * kstep;
            const char* a3 = a2 + kstep; const char* b3 = b2 + kstep;
            if constexpr (SP2) {
            PG8_LDB(B0, 0, 0); PG8_LDB(B1, 0, 1); PG8_SCHED; PG8_LDA(At, 0, 0); PG8_STAGE(PG8_SA(1, 1), a1 + hstepA, voffA);
            PG8_WAIT_V(8); PG8_WAIT_L(0); PG8_BAR; PG8_MMA(0, 0, At, B0); PG8_MMA(0, 1, At, B1); PG8_BAR; PG8_SCHED;
            PG8_LDA(At, 0, 1); PG8_STAGE(PG8_SB(0, 0), b2, voffB); PG8_STAGE(PG8_SB(0, 1), b2 + hstepB, voffB); PG8_STAGE(PG8_SA(0, 0), a2, voffA);
            PG8_WAIT_V(8); PG8_WAIT_L(0); PG8_BAR; PG8_MMA(1, 0, At, B0); PG8_MMA(1, 1, At, B1); PG8_BAR; PG8_SCHED;
            PG8_LDB(B0, 1, 0); PG8_LDB(B1, 1, 1); PG8_SCHED; PG8_LDA(At, 1, 0); PG8_STAGE(PG8_SA(0, 1), a2 + hstepA, voffA);
            PG8_WAIT_V(8); PG8_WAIT_L(0); PG8_BAR; PG8_MMA(0, 0, At, B0); PG8_MMA(0, 1, At, B1); PG8_BAR; PG8_SCHED;
            PG8_LDA(At, 1, 1); PG8_STAGE(PG8_SB(1, 0), b3, voffB); PG8_STAGE(PG8_SB(1, 1), b3 + hstepB, voffB); PG8_STAGE(PG8_SA(1, 0), a3, voffA);
            PG8_WAIT_V(8); PG8_WAIT_L(0); PG8_BAR; PG8_MMA(1, 0, At, B0); PG8_MMA(1, 1, At, B1); PG8_BAR; PG8_SCHED;
            } else {
            PG8_LDB(B0, 0, 0); PG8_SCHED; PG8_LDA(At, 0, 0); PG8_STAGE(PG8_SA(1, 1), a1 + hstepA, voffA);
            PG8_WAIT_L(8); PG8_BAR; PG8_WAIT_L(0); PG8_MMA(0, 0, At, B0); PG8_BAR; PG8_SCHED;
            PG8_LDB(B1, 0, 1); PG8_STAGE(PG8_SB(0, 0), b2, voffB);
            PG8_BAR; PG8_WAIT_L(0); PG8_MMA(0, 1, At, B1); PG8_BAR;
            PG8_LDA(At, 0, 1); PG8_STAGE(PG8_SA(0, 0), a2, voffA);
            PG8_BAR; PG8_WAIT_L(0); PG8_MMA(1, 0, At, B0); PG8_BAR; PG8_SCHED;
            PG8_STAGE(PG8_SB(0, 1), b2 + hstepB, voffB);
            PG8_WAIT_V(6); PG8_BAR; PG8_MMA(1, 1, At, B1); PG8_BAR;
            PG8_LDB(B0, 1, 0); PG8_SCHED; PG8_LDA(At, 1, 0); PG8_STAGE(PG8_SA(0, 1), a2 + hstepA, voffA);
            PG8_WAIT_L(8); PG8_BAR; PG8_WAIT_L(0); PG8_MMA(0, 0, At, B0); PG8_BAR; PG8_SCHED;
            PG8_LDB(B1, 1, 1); PG8_STAGE(PG8_SB(1, 0), b3, voffB);
            PG8_BAR; PG8_WAIT_L(0); PG8_MMA(0, 1, At, B1); PG8_BAR;
            PG8_LDA(At, 1, 1); PG8_STAGE(PG8_SA(1, 0), a3, voffA);
            PG8_BAR; PG8_WAIT_L(0); PG8_MMA(1, 0, At, B0); PG8_BAR; PG8_SCHED;
            PG8_STAGE(PG8_SB(1, 1), b3 + hstepB, voffB);
            PG8_WAIT_V(6); PG8_BAR; PG8_MMA(1, 1, At, B1); PG8_BAR;
            }
        }
        if constexpr (ALIGN_EPI) { if (wr == 0) PG8_BAR; }
        E(acc, cur, wr, wc, fr, fq);
        if (!has_next) break;
#pragma unroll
        for (int a = 0; a < 2; ++a)
#pragma unroll
            for (int b = 0; b < 2; ++b)
#pragma unroll
                for (int m = 0; m < 4; ++m)
#pragma unroll
                    for (int n = 0; n < 2; ++n) acc[a][b][m][n] = (f32x4){0.f, 0.f, 0.f, 0.f};
        cur = nxt; cA = nA; cB = nB; ++ui;
        if constexpr (ALIGN_EPI) { if (wr == 1) PG8_BAR; }
    }
    PG8_WAIT_V(0);
    if constexpr (!ALIGN_EPI) { if (wr == 0) PG8_BAR; }
    PG8_BAR;
#undef PG8_UA
#undef PG8_UB
#undef PG8_SA
#undef PG8_SB
#undef PG8_STAGE
#undef PG8_LDA
#undef PG8_LDB
#undef PG8_MMA
#undef PG8_WAIT_V
#undef PG8_WAIT_L
#undef PG8_BAR
#undef PG8_SCHED
}
}

namespace att {
using bf16 = __hip_bfloat16;
constexpr int D = 128, NW = 8, QBLK = 32, KVBLK = 64;
constexpr float SCALE = 0.088388347648318440f;
constexpr float THR = 8.f;
constexpr int LDQ = 2048, LDK = 512, LDO = 2048;
constexpr size_t SHM_V = KVBLK * D * 2, SHM_K = KVBLK * D * 2, SHM_ATTN = 2 * SHM_V + 2 * SHM_K + NW * 64 * 4;
#define KSWZ(row, colB) ((row) * 256 + ((colB) ^ (((row) & 7) << 4)))
#define SBAR() __builtin_amdgcn_sched_barrier(0)
__device__ __forceinline__ int crow(int r, int hi) { return (r & 3) + 8 * (r >> 2) + 4 * hi; }
__device__ __forceinline__ unsigned cvtpk(float lo, float hi) { unsigned r; asm volatile("v_cvt_pk_bf16_f32 %0, %1, %2" : "=v"(r) : "v"(lo), "v"(hi)); return r; }
__device__ __forceinline__ bf16x8 ld8(const bf16* p) { return *reinterpret_cast<const bf16x8*>(p); }

__device__ __forceinline__ void partialSM(f32x16& p0, f32x16& p1, float& m_reg, float& mn, float& alpha) {
  constexpr float C = SCALE * 1.4426950408889634f;
  float pmax = p0[0]; for (int r = 1; r < 16; ++r) pmax = fmaxf(pmax, p0[r]); for (int r = 0; r < 16; ++r) pmax = fmaxf(pmax, p1[r]);
  { auto rr = __builtin_amdgcn_permlane32_swap(__float_as_uint(pmax), __float_as_uint(pmax), false, false);
    pmax = fmaxf(__uint_as_float(rr[0]), __uint_as_float(rr[1])); }
  if (__builtin_expect(__all(pmax - m_reg <= THR / SCALE), 1)) { mn = m_reg; alpha = 1.f; }
  else { mn = fmaxf(m_reg, pmax); alpha = __builtin_amdgcn_exp2f((m_reg - mn) * C); m_reg = mn; }
  float mnC = -mn * C;
  for (int r = 0; r < 16; ++r) p0[r] = fmaf(p0[r], C, mnC); for (int r = 0; r < 16; ++r) p1[r] = fmaf(p1[r], C, mnC);
  for (int r = 0; r < 16; ++r) p0[r] = __builtin_amdgcn_exp2f(p0[r]);
}
__device__ __forceinline__ void finishSM(f32x16& p0, f32x16& p1, float alpha, float& l_reg, bf16x8& pa0, bf16x8& pa1, bf16x8& pa2, bf16x8& pa3) {
  for (int r = 0; r < 16; ++r) p1[r] = __builtin_amdgcn_exp2f(p1[r]);
  float ps = 0; for (int r = 0; r < 16; ++r) ps += p0[r]; for (int r = 0; r < 16; ++r) ps += p1[r];
  { auto rr = __builtin_amdgcn_permlane32_swap(__float_as_uint(ps), __float_as_uint(ps), false, false);
    ps = __uint_as_float(rr[0]) + __uint_as_float(rr[1]); }
  l_reg = l_reg * alpha + ps;
#define PK4(P, BASE, OUT) do { unsigned a0 = cvtpk(P[BASE + 0], P[BASE + 1]), a1 = cvtpk(P[BASE + 2], P[BASE + 3]);   \
    unsigned b0 = cvtpk(P[BASE + 4], P[BASE + 5]), b1 = cvtpk(P[BASE + 6], P[BASE + 7]);                              \
    auto r0 = __builtin_amdgcn_permlane32_swap(a0, b0, false, false); auto r1 = __builtin_amdgcn_permlane32_swap(a1, b1, false, false); \
    u32x4 w = {r0[0], r1[0], r0[1], r1[1]}; OUT = *reinterpret_cast<bf16x8*>(&w); } while (0)
  PK4(p0, 0, pa0); PK4(p0, 8, pa1); PK4(p1, 0, pa2); PK4(p1, 8, pa3);
#undef PK4
}
__device__ __forceinline__ void qkt(f32x16& p0, f32x16& p1, const bf16* Ks, const bf16x8* qr, int r32, int hi) {
  p0 = f32x16{}; p1 = f32x16{};
  for (int d0 = 0; d0 < 8; ++d0) { int cb = (d0 * 16 + hi * 8) * 2;
    bf16x8 b0 = *reinterpret_cast<const bf16x8*>((const char*)Ks + KSWZ(r32, cb));
    bf16x8 b1 = *reinterpret_cast<const bf16x8*>((const char*)Ks + KSWZ(32 + r32, cb));
    p0 = __builtin_amdgcn_mfma_f32_32x32x16_bf16(b0, qr[d0], p0, 0, 0, 0);
    p1 = __builtin_amdgcn_mfma_f32_32x32x16_bf16(b1, qr[d0], p1, 0, 0, 0); }
}
__device__ __forceinline__ int v_st(int k, int c) { const int kk = (k & ~0xC) | ((k & 4) << 1) | ((k & 8) >> 1); return ((kk >> 3) * 4 + (c >> 5)) * 512 + ((kk & 7) * 32 + (c & 31)) * 2; }
__device__ __forceinline__ int v_rd_base(int lane) { return ((lane & 3) << 3) | (((lane >> 2) & 3) << 6) | (((lane >> 4) & 1) << 5) | (((lane >> 5) & 1) << 8); }
constexpr int v_rd_off(int d0, int ks, int half) { return d0 * 512 + ks * 4096 + half * 2048; }
template <int OFF> __device__ __forceinline__ s16x4 tr_read(int vb) {
  s16x4 r; asm volatile("ds_read_b64_tr_b16 %0, %1 offset:%2" : "=&v"(r) : "v"(vb), "i"(OFF) : "memory"); return r;
}
template <int D0> __device__ __forceinline__ void pv_one(f32x16& od, int vb, bf16x8 pa0, bf16x8 pa1, bf16x8 pa2, bf16x8 pa3) {
  const s16x4 l0 = tr_read<v_rd_off(D0, 0, 0)>(vb), h0 = tr_read<v_rd_off(D0, 0, 1)>(vb), l1 = tr_read<v_rd_off(D0, 1, 0)>(vb), h1 = tr_read<v_rd_off(D0, 1, 1)>(vb);
  const s16x4 l2 = tr_read<v_rd_off(D0, 2, 0)>(vb), h2 = tr_read<v_rd_off(D0, 2, 1)>(vb), l3 = tr_read<v_rd_off(D0, 3, 0)>(vb), h3 = tr_read<v_rd_off(D0, 3, 1)>(vb);
  asm volatile("s_waitcnt lgkmcnt(0)" ::: "memory"); SBAR();
#define PK(L, H) (bf16x8){L[0], L[1], L[2], L[3], H[0], H[1], H[2], H[3]}
  od = __builtin_amdgcn_mfma_f32_32x32x16_bf16(pa0, PK(l0, h0), od, 0, 0, 0);
  od = __builtin_amdgcn_mfma_f32_32x32x16_bf16(pa1, PK(l1, h1), od, 0, 0, 0);
  od = __builtin_amdgcn_mfma_f32_32x32x16_bf16(pa2, PK(l2, h2), od, 0, 0, 0);
  od = __builtin_amdgcn_mfma_f32_32x32x16_bf16(pa3, PK(l3, h3), od, 0, 0, 0);
#undef PK
}
__device__ __forceinline__ void pv_d0(f32x16* o, int vb, bf16x8 pa0, bf16x8 pa1, bf16x8 pa2, bf16x8 pa3) {
  pv_one<0>(o[0], vb, pa0, pa1, pa2, pa3); pv_one<1>(o[1], vb, pa0, pa1, pa2, pa3); pv_one<2>(o[2], vb, pa0, pa1, pa2, pa3); pv_one<3>(o[3], vb, pa0, pa1, pa2, pa3);
}

__device__ __forceinline__ void attn_dense_body(const bf16* __restrict__ Qb, const bf16* __restrict__ Kh, const bf16* __restrict__ Vh,
                                                bf16* __restrict__ Ob, int seq, char* lds, const int tid) {
  const int wid = tid >> 6, lane = tid & 63, r32 = lane & 31, hi = lane >> 5;
  bf16* V_lds = (bf16*)lds; bf16* K_lds = (bf16*)(lds + 2 * SHM_V);
  float* ws = (float*)(lds + 2 * SHM_V + 2 * SHM_K) + wid * 64; float* li_l = ws; float* al_l = ws + 32;
  float m_reg = -1e30f, l_reg = 0; f32x16 o[4] = {}; bf16x8 qr[8];
  const bf16* Qw = Qb + (long)(wid * QBLK + r32) * LDQ + hi * 8;
#pragma unroll
  for (int d0 = 0; d0 < 8; ++d0) qr[d0] = ld8(Qw + d0 * 16);
  const int sr = tid >> 4, sc = (tid & 15) * 8, vst0 = v_st(sr, sc), vst1 = v_st(32 + sr, sc);
  const int vb0 = (int)(uintptr_t)V_lds + v_rd_base(lane);
  struct { bf16x8 vs0, vs1, ks0, ks1; } sr_[2];
#define SLOAD(i, k0) do { sr_[i].vs0 = ld8(&Vh[(long)((k0) + sr) * LDK + sc]); sr_[i].vs1 = ld8(&Vh[(long)((k0) + 32 + sr) * LDK + sc]); \
    sr_[i].ks0 = ld8(&Kh[(long)((k0) + sr) * LDK + sc]); sr_[i].ks1 = ld8(&Kh[(long)((k0) + 32 + sr) * LDK + sc]); } while (0)
#define SWRITE(b, i) do { *(bf16x8*)((char*)V_lds + (b) * SHM_V + vst0) = sr_[i].vs0;          \
    *(bf16x8*)((char*)V_lds + (b) * SHM_V + vst1) = sr_[i].vs1; int kc = sc * 2;               \
    *(bf16x8*)((char*)K_lds + (b) * SHM_K + KSWZ(sr, kc)) = sr_[i].ks0;                       \
    *(bf16x8*)((char*)K_lds + (b) * SHM_K + KSWZ(32 + sr, kc)) = sr_[i].ks1; } while (0)
#define SWAIT() asm volatile("s_waitcnt vmcnt(4)" ::: "memory")
#define RESC(a) do { if (__any((a) < 1.f)) { if (hi == 0) al_l[r32] = (a); asm volatile("s_waitcnt lgkmcnt(0)" ::: "memory"); \
    for (int d = 0; d < 4; ++d) for (int r = 0; r < 16; ++r) o[d][r] *= al_l[crow(r, hi)]; } } while (0)
  f32x16 pA0, pA1, pB0, pB1; float mnA, mnB, alA, alB; bf16x8 pa0, pa1, pa2, pa3; const int NT = seq / KVBLK;
  constexpr int SE = 0, SO = 1;
  SLOAD(SE, 0); asm volatile("s_waitcnt vmcnt(0)" ::: "memory"); SWRITE(0, SE); __syncthreads();
  qkt(pA0, pA1, K_lds, qr, r32, hi); partialSM(pA0, pA1, m_reg, mnA, alA);
  SLOAD(SO, KVBLK); if (2 < NT) SLOAD(SE, 2 * KVBLK);
  SWAIT(); SWRITE(1, SO); __syncthreads();
  for (int j = 1; j + 1 < NT; j += 2) {
    SBAR(); qkt(pB0, pB1, (bf16*)((char*)K_lds + SHM_K), qr, r32, hi);
    finishSM(pA0, pA1, alA, l_reg, pa0, pa1, pa2, pa3); SBAR();
    SLOAD(SO, (j + 2) * KVBLK); SBAR();
    pv_d0(o, vb0, pa0, pa1, pa2, pa3); partialSM(pB0, pB1, m_reg, mnB, alB);
    __syncthreads(); SWAIT(); SWRITE(0, SE);
    RESC(alB); __syncthreads();
    SBAR(); qkt(pA0, pA1, K_lds, qr, r32, hi);
    finishSM(pB0, pB1, alB, l_reg, pa0, pa1, pa2, pa3); SBAR();
    if (j + 3 < NT) SLOAD(SE, (j + 3) * KVBLK); SBAR();
    pv_d0(o, vb0 + (int)SHM_V, pa0, pa1, pa2, pa3); partialSM(pA0, pA1, m_reg, mnA, alA);
    __syncthreads(); SWAIT(); SWRITE(1, SO);
    RESC(alA); __syncthreads();
  }
  SBAR(); qkt(pB0, pB1, (bf16*)((char*)K_lds + SHM_K), qr, r32, hi);
  finishSM(pA0, pA1, alA, l_reg, pa0, pa1, pa2, pa3); SBAR();
  pv_d0(o, vb0, pa0, pa1, pa2, pa3); partialSM(pB0, pB1, m_reg, mnB, alB);
  __syncthreads(); RESC(alB);
  finishSM(pB0, pB1, alB, l_reg, pa0, pa1, pa2, pa3); SBAR();
  pv_d0(o, vb0 + (int)SHM_V, pa0, pa1, pa2, pa3);
  if (hi == 0) li_l[r32] = l_reg; asm volatile("s_waitcnt lgkmcnt(0)" ::: "memory");
  float rli[16];
#pragma unroll
  for (int r = 0; r < 16; ++r) rli[r] = __builtin_amdgcn_rcpf(li_l[crow(r, hi)]);
  bf16* Ow = Ob + (long)(wid * QBLK) * LDO;
#pragma unroll
  for (int r = 0; r < 16; ++r) { int orow = crow(r, hi);
    for (int d0 = 0; d0 < 4; ++d0) Ow[(long)orow * LDO + d0 * 32 + r32] = __float2bfloat16(o[d0][r] * rli[r]); }
  __syncthreads();
#undef SLOAD
#undef SWRITE
#undef SWAIT
#undef RESC
}
#undef KSWZ
#undef SBAR
}

#define XB_TMO      128
#define XB_XCNT(j)  (256  + 64 * (j))
#define XB_XSUB(j)  (1280 + 64 * (j))
#define XB_XGEN(j)  (2304 + 64 * (j))
#define XB_TOP      3328
#define XB_TOPGEN   3392
#define XCD_BAR_WORDS 3456
#define XB_SPIN_CAP (1u << 18)
__device__ __forceinline__ unsigned xb_ld(unsigned* p)              { return __hip_atomic_load(p, __ATOMIC_RELAXED, __HIP_MEMORY_SCOPE_AGENT); }
__device__ __forceinline__ unsigned xb_add(unsigned* p, unsigned v) { return __hip_atomic_fetch_add(p, v, __ATOMIC_RELAXED, __HIP_MEMORY_SCOPE_AGENT); }
__device__ __forceinline__ unsigned xb_xcc_id() { return (unsigned)__builtin_amdgcn_s_getreg((3 << 11) | 20) & 0xFu; }
#define XB_SPIN(cond, bar) do { unsigned _sp = 0; while (cond) { __builtin_amdgcn_s_sleep(1); \
    if ((++_sp & 255u) == 0u) { if (xb_ld(&(bar)[XB_TMO])) break; if (_sp > XB_SPIN_CAP) { atomicAdd(&(bar)[XB_TMO], 1u); break; } } } } while (0)
struct XcdBarrier { unsigned* bar; unsigned x; volatile LAS unsigned* st; };
__device__ __forceinline__ XcdBarrier xcd_barrier_post(unsigned* bar, volatile LAS unsigned* st) {
    XcdBarrier b; b.bar = bar; b.x = xb_xcc_id(); b.st = st;
    if (threadIdx.x == 0) (void)xb_add(&bar[XB_XCNT(b.x)], 1u);
    return b;
}
__device__ __forceinline__ void xcd_barrier_complete(unsigned* bar, unsigned x, unsigned& nloc, unsigned& nx) {
    const unsigned G = gridDim.x * gridDim.y * gridDim.z;
    unsigned sum, cnt, mine, sp = 0u;
    for (;;) {
        sum = 0u; cnt = 0u; mine = 0u;
#pragma unroll
        for (unsigned j = 0; j < 16; ++j) { const unsigned c = xb_ld(&bar[XB_XCNT(j)]); sum += c; cnt += (c > 0u) ? 1u : 0u; mine = (j == x) ? c : mine; }
        if (sum == G) break;
        __builtin_amdgcn_s_sleep(1);
        if ((++sp & 255u) == 0u) { if (xb_ld(&bar[XB_TMO])) break; if (sp > XB_SPIN_CAP) { atomicAdd(&bar[XB_TMO], 1u); break; } }
    }
    nloc = mine > 0u ? mine : 1u; nx = cnt > 0u ? cnt : 1u;
}
__device__ __forceinline__ void xcd_barrier(const XcdBarrier& b) {
    asm volatile("s_waitcnt vmcnt(0)" ::: "memory");
    __syncthreads();
    if (threadIdx.x == 0) {
        unsigned* bar = b.bar;
        __builtin_amdgcn_s_waitcnt(0);
        unsigned nloc = b.st[0], nx = b.st[1];
        if (nloc == 0u) { xcd_barrier_complete(bar, b.x, nloc, nx); b.st[0] = nloc; b.st[1] = nx; }
        const unsigned old = xb_add(&bar[XB_XSUB(b.x)], 1u);
        const unsigned gen = old / nloc;
        if (old + 1u == (gen + 1u) * nloc) {
            __builtin_amdgcn_fence(__ATOMIC_RELEASE, "agent");
            asm volatile("s_waitcnt vmcnt(0)" ::: "memory");
            const unsigned og = xb_add(&bar[XB_TOP], 1u);
            const unsigned tg = og / nx;
            if (og + 1u == (tg + 1u) * nx) xb_add(&bar[XB_TOPGEN], 1u);
            else XB_SPIN(xb_ld(&bar[XB_TOPGEN]) == tg, bar);
            __builtin_amdgcn_fence(__ATOMIC_ACQUIRE, "agent");
            xb_add(&bar[XB_XGEN(b.x)], 1u);
            asm volatile("s_waitcnt vmcnt(0)" ::: "memory");
        } else {
            XB_SPIN(xb_ld(&bar[XB_XGEN(b.x)]) == gen, bar);
            __builtin_amdgcn_fence(__ATOMIC_ACQUIRE, "agent");
            asm volatile("s_waitcnt vmcnt(0)" ::: "memory");
        }
    }
    __syncthreads();
}

__device__ __forceinline__ void transpose_item(const float* W, int K, int N, bf16_t* WT, int glu_perm, LAS float* scr, int item, int lane, const float* colscale = nullptr) {
    const int nblk = N / 32, kb = item / nblk, nb = item % nblk, k0 = 64 * kb, n0 = 32 * nb;
    int r0 = n0;
    if (glu_perm && n0 < 2048) { const int half = n0 >> 10, ch = n0 & 1023; r0 = (ch >> 7) * 256 + half * 128 + (ch & 127); }
    const int lr = lane >> 3, c4 = (lane & 7) * 4;
    f32x4 v[8];
#pragma unroll
    for (int i = 0; i < 8; ++i) v[i] = *(const f32x4*)(W + (size_t)(k0 + lr + 8 * i) * N + n0 + c4);
    const f32x4 csc = colscale ? *(const f32x4*)(colscale + n0 + c4) : (f32x4){1.f, 1.f, 1.f, 1.f};
#pragma unroll
    for (int i = 0; i < 8; ++i) { LAS float* d = scr + (lr + 8 * i) * 33 + c4; const f32x4 w = v[i] * csc; d[0] = w.x; d[1] = w.y; d[2] = w.z; d[3] = w.w; }
    asm volatile("s_waitcnt lgkmcnt(0)" ::: "memory");
    const int c = lane & 7;
#pragma unroll
    for (int j = 0; j < 4; ++j) { const int n = (lane >> 3) + 8 * j; const LAS float* sp = scr + (8 * c) * 33 + n;
        u32x4 o; o.x = cvt_pk_bf16(sp[0 * 33], sp[1 * 33]); o.y = cvt_pk_bf16(sp[2 * 33], sp[3 * 33]); o.z = cvt_pk_bf16(sp[4 * 33], sp[5 * 33]); o.w = cvt_pk_bf16(sp[6 * 33], sp[7 * 33]);
        *(u32x4*)(WT + (size_t)(r0 + n) * K + k0 + 8 * c) = o; }
    asm volatile("s_waitcnt lgkmcnt(0)" ::: "memory");
}

__device__ __forceinline__ void norm_finish(const f32x4 (&v)[8], const float* sh, const float* sc, bf16_t* orow, int lane) {
    float s = 0.f;
#pragma unroll
    for (int j = 0; j < 8; ++j) s += (v[j].x * v[j].x + v[j].y * v[j].y) + (v[j].z * v[j].z + v[j].w * v[j].w);
    const float rstd = 1.0f / sqrtf(wave_sum(s) * (1.f / DM) + EPS);
    u32x2* o8 = (u32x2*)orow + lane;
#pragma unroll
    for (int j = 0; j < 8; ++j) { const f32x4 a = ((const f32x4*)sc)[lane + 64 * j], b = ((const f32x4*)sh)[lane + 64 * j]; const f32x4 y = v[j] * rstd * (a + 1.0f) + b;
        u32x2 w; w.x = cvt_pk_bf16(y.x, y.y); w.y = cvt_pk_bf16(y.z, y.w); o8[64 * j] = w; }
}
__device__ __forceinline__ void norm_mod_row(const float* xrow, const float* sh, const float* sc, bf16_t* orow, int lane) {
    const f32x4* xr = (const f32x4*)xrow + lane; f32x4 v[8];
#pragma unroll
    for (int j = 0; j < 8; ++j) v[j] = xr[64 * j];
    norm_finish(v, sh, sc, orow, lane);
}
__device__ __forceinline__ void norm_mod_row_parts(const float* base, const float* gate, const float* part, int S, float* xout, const float* sh, const float* sc, bf16_t* orow, int lane) {
    f32x4 v[8], a[8];
#pragma unroll
    for (int j = 0; j < 8; ++j) { v[j] = ((const f32x4*)base)[lane + 64 * j]; a[j] = (f32x4){0.f, 0.f, 0.f, 0.f}; }
    for (int sl = 0; sl < S; ++sl) { const f32x4* pp = (const f32x4*)(part + (size_t)sl * 256 * DM) + lane;
#pragma unroll
        for (int j = 0; j < 8; ++j) a[j] += pp[64 * j]; }
#pragma unroll
    for (int j = 0; j < 8; ++j) { v[j] += ((const f32x4*)gate)[lane + 64 * j] * a[j]; ((f32x4*)xout)[lane + 64 * j] = v[j]; }
    norm_finish(v, sh, sc, orow, lane);
}

template <int W> __device__ __forceinline__ void pool_chunk(const float* U, bf16_t* Dd, int row0, int seq_lo, int seq_hi, int ch) {
    f32x2 in[W + 7];
#pragma unroll
    for (int i = 0; i < W + 7; ++i) { const int r = row0 - W / 2 + i; const bool ok = (r >= seq_lo) && (r < seq_hi);
        in[i] = ok ? *(const f32x2*)(U + (size_t)r * 1024 + ch) : (f32x2){0.f, 0.f}; }
#pragma unroll
    for (int o = 0; o < 8; ++o) { f32x2 s = {0.f, 0.f};
#pragma unroll
        for (int j = 0; j < W; ++j) s += in[o + j];
        const int t = row0 + o; const int lo = max(t - W / 2, seq_lo), hi = min(t - W / 2 + W, seq_hi); const float inv = 1.0f / (float)(hi - lo);
        const f32x2 d = s * inv - in[o + W / 2];
        *(unsigned*)(Dd + (size_t)t * 1024 + ch) = cvt_pk_bf16(d.x, d.y); }
}

struct Params { const float* in[25]; float* out; unsigned char* ws; };

__global__ void __launch_bounds__(512, 2) fwd_mega(Params p) {
    extern __shared__ __attribute__((aligned(16))) unsigned char lds_raw[];
    cg::grid_group grid = cg::this_grid();
    LAS unsigned char* lds = (LAS unsigned char*)lds_raw;
    const int G = gridDim.x, bx = blockIdx.x;
#define PHASE_BEGIN() int tid = threadIdx.x; asm volatile("" : "+v"(tid)); size_t wz_ = 0; asm volatile("" : "+s"(wz_)); unsigned char* ws = p.ws + wz_; \
    const int lane = tid & 63, wave = __builtin_amdgcn_readfirstlane(tid >> 6); const int gw = bx * 8 + wave, NGW = G * 8; (void)lane; (void)gw; (void)NGW; \
    float* MODS = (float*)(ws + WS_MODS); (void)MODS
#define DEFP(T, name, off) T* name = (T*)(ws + (off))
    volatile LAS unsigned* MISC = (volatile LAS unsigned*)(lds + 131072 + 320);
    if (threadIdx.x < 32) MISC[threadIdx.x] = 0u;
    __syncthreads();
    const XcdBarrier xbar = xcd_barrier_post((unsigned*)(p.ws + WS_BAR), MISC + 8);
#define GRID_BAR() xcd_barrier(xbar)
#define MOD(l, cnd, chunk) (MODS + ((l) * 2 + (cnd)) * NMODV + (chunk) * DM)

    {
        PHASE_BEGIN();
        LAS float* sS = (LAS float*)lds;
        LAS float* red = (LAS float*)(lds + 16384);
        for (int k = tid; k < DM; k += 512) { const float a = p.in[1][k], b = p.in[3][k]; sS[k] = a / (1.0f + expf(-a)); sS[DM + k] = b / (1.0f + expf(-b)); }
        __syncthreads();
        const int cgi = tid & 7, ks = tid >> 3;
        for (int item = bx; item < 768; item += G) {
            const int l = item / 384, col0 = (item % 384) * 32;
            const float* Wa = l ? p.in[16] : p.in[4]; const float* bvec = l ? p.in[17] : p.in[5];
            f32x4 a0 = {0.f, 0.f, 0.f, 0.f}, a1 = {0.f, 0.f, 0.f, 0.f};
            const float* wp = Wa + (size_t)(ks * 32) * NMODV + col0 + cgi * 4;
#pragma unroll 8
            for (int kk = 0; kk < 32; ++kk) { const f32x4 w = *(const f32x4*)(wp + (size_t)kk * NMODV); const float s0 = sS[ks * 32 + kk], s1 = sS[DM + ks * 32 + kk]; a0 += w * s0; a1 += w * s1; }
            *(LAS f32x4*)(red + (ks * 8 + cgi) * 8) = a0; *(LAS f32x4*)(red + (ks * 8 + cgi) * 8 + 4) = a1;
            __syncthreads();
            if (tid < 64) { float s = 0.f;
#pragma unroll 8
                for (int q = 0; q < 64; ++q) s += red[q * 64 + tid];
                const int cnd = (tid >> 2) & 1, colj = (tid >> 3) * 4 + (tid & 3);
                MODS[(l * 2 + cnd) * NMODV + col0 + colj] = s + bvec[col0 + colj]; }
            __syncthreads();
        }
        __syncthreads();
        LAS float* scr = (LAS float*)(lds + wave * 16384);
        constexpr int I_IN = 32 * 96, I_OUT = 32 * 64, I_UP = 32 * 256, I_DN = 128 * 64, I_PW = 4 * 8;
        constexpr int NITEMS = 2 * (I_IN + I_OUT + I_UP + I_DN) + 4 * I_PW;
        for (int it = gw; it < NITEMS; it += NGW) {
            int r = it;
            if (r < I_IN) { transpose_item(p.in[6], DM, DIN, (bf16_t*)(ws + WS_WIN0), 1, scr, r, lane); continue; } r -= I_IN;
            if (r < I_OUT) { transpose_item(p.in[13], DM, DM, (bf16_t*)(ws + WS_WOUT0), 0, scr, r, lane); continue; } r -= I_OUT;
            if (r < I_UP) { transpose_item(p.in[14], DM, DFF, (bf16_t*)(ws + WS_WUP0), 0, scr, r, lane); continue; } r -= I_UP;
            if (r < I_DN) { transpose_item(p.in[15], DFF, DM, (bf16_t*)(ws + WS_WDN0), 0, scr, r, lane); continue; } r -= I_DN;
            if (r < I_IN) { transpose_item(p.in[18], DM, DIN, (bf16_t*)(ws + WS_WQKV1), 0, scr, r, lane); continue; } r -= I_IN;
            if (r < I_OUT) { transpose_item(p.in[21], DM, DM, (bf16_t*)(ws + WS_WOUT1), 0, scr, r, lane); continue; } r -= I_OUT;
            if (r < I_UP) { transpose_item(p.in[22], DM, DFF, (bf16_t*)(ws + WS_WUP1), 0, scr, r, lane); continue; } r -= I_UP;
            if (r < I_DN) { transpose_item(p.in[23], DFF, DM, (bf16_t*)(ws + WS_WDN1), 0, scr, r, lane); continue; } r -= I_DN;
            { const int gidx = r / I_PW; transpose_item(p.in[11] + (size_t)gidx * 65536, 256, 256, (bf16_t*)(ws + WS_WPOOL) + (size_t)gidx * 65536, 0, scr, r % I_PW, lane, p.in[12] + gidx * 256); }
        }
    }
    grid.sync();

    {
        PHASE_BEGIN(); DEFP(bf16_t, XN, WS_XN);
        for (int row = gw; row < MT; row += NGW) {
            const bool isc = row >= SEQ;
            norm_mod_row(isc ? p.in[2] + (size_t)(row - SEQ) * DM : p.in[0] + (size_t)row * DM, MOD(0, isc ? 1 : 0, 0), MOD(0, isc ? 1 : 0, 1), XN + (size_t)row * DM, lane);
        }
    }
    GRID_BAR();

    {
        PHASE_BEGIN(); DEFP(bf16_t, XN, WS_XN); DEFP(bf16_t, W_IN0, WS_WIN0); DEFP(float, GLU, WS_GLU); DEFP(float, U, WS_U);
        pg8::Gemm g{XN, W_IN0, MT, DIN, DM, DM, DM, 0}; pg8::StaticOrder S; S.init(MT, DIN, DM, G, bx);
        pg8::EpiGlu E{GLU, U};
        pg8::gemm_phase<pg8::EpiGlu, pg8::StaticOrder, true, true>(lds, g, S, E, tid);
    }
    GRID_BAR();

    {
        PHASE_BEGIN(); DEFP(float, GLU, WS_GLU); DEFP(float, U, WS_U); DEFP(bf16_t, YC, WS_YC); DEFP(bf16_t, Dd, WS_D);
        const int ch = 2 * tid;
        f32x2 cw[31];
#pragma unroll
        for (int j = 0; j < 31; ++j) cw[j] = *(const f32x2*)(p.in[7] + j * 1024 + ch);
        const f32x2 cb = *(const f32x2*)(p.in[8] + ch), lg = *(const f32x2*)(p.in[9] + ch), lb = *(const f32x2*)(p.in[10] + ch);
        LAS float* red1 = (LAS float*)lds; LAS float* red2 = (LAS float*)(lds + 256);
        for (int chunk = bx; chunk < MT / 8; chunk += G) {
            const int row0 = chunk * 8; const int seq_lo = row0 < SEQ ? 0 : SEQ, seq_hi = row0 < SEQ ? SEQ : MT;
            f32x2 acc[8];
#pragma unroll
            for (int o = 0; o < 8; ++o) acc[o] = cb;
#pragma unroll
            for (int i = 0; i < 38; ++i) { const int r = row0 - 15 + i; const bool ok = (r >= seq_lo) && (r < seq_hi);
                const f32x2 xv = ok ? *(const f32x2*)(GLU + (size_t)r * 1024 + ch) : (f32x2){0.f, 0.f};
#pragma unroll
                for (int o = 0; o < 8; ++o) { const int j = i - o; if (j >= 0 && j < 31) acc[o] += xv * cw[j]; } }
            float s[8];
#pragma unroll
            for (int o = 0; o < 8; ++o) s[o] = wave_sum(acc[o].x + acc[o].y);
            if (lane == 0) {
#pragma unroll
                for (int o = 0; o < 8; ++o) red1[wave * 8 + o] = s[o]; }
            __syncthreads();
#pragma unroll
            for (int o = 0; o < 8; ++o) { float t = 0.f;
#pragma unroll
                for (int w = 0; w < 8; ++w) t += red1[w * 8 + o];
                const float mean = t * (1.f / 1024.f); acc[o] = acc[o] - mean; s[o] = wave_sum(acc[o].x * acc[o].x + acc[o].y * acc[o].y); }
            if (lane == 0) {
#pragma unroll
                for (int o = 0; o < 8; ++o) red2[wave * 8 + o] = s[o]; }
            __syncthreads();
#pragma unroll
            for (int o = 0; o < 8; ++o) { float t = 0.f;
#pragma unroll
                for (int w = 0; w < 8; ++w) t += red2[w * 8 + o];
                const float rstd = 1.0f / sqrtf(t * (1.f / 1024.f) + EPS);
                const f32x2 y = acc[o] * rstd * lg + lb;
                const float y0 = y.x * sigmoidf_(y.x), y1 = y.y * sigmoidf_(y.y);
                *(unsigned*)(YC + (size_t)(row0 + o) * DM + ch) = cvt_pk_bf16(y0, y1); }
            const int pg = wave >> 1;
            if (pg == 0) pool_chunk<2>(U, Dd, row0, seq_lo, seq_hi, ch);
            else if (pg == 1) pool_chunk<4>(U, Dd, row0, seq_lo, seq_hi, ch);
            else if (pg == 2) pool_chunk<8>(U, Dd, row0, seq_lo, seq_hi, ch);
            else pool_chunk<16>(U, Dd, row0, seq_lo, seq_hi, ch);
        }
    }
    GRID_BAR();

    {
        PHASE_BEGIN(); DEFP(bf16_t, Dd, WS_D); DEFP(bf16_t, W_POOL, WS_WPOOL); DEFP(bf16_t, YC, WS_YC);
        pg8::Gemm g{Dd, W_POOL, MT, 1024, 256, 1024, 256, 256}; pg8::StaticOrder S; S.init(MT, 1024, 256, G, bx);
        pg8::EpiBf16<0, false> E{YC, DM, 1024, nullptr};
        pg8::gemm_phase<pg8::EpiBf16<0, false>, pg8::StaticOrder, true, true>(lds, g, S, E, tid);
    }
    GRID_BAR();

    {
        PHASE_BEGIN(); DEFP(bf16_t, YC, WS_YC); DEFP(bf16_t, W_OUT0, WS_WOUT0); DEFP(float, XR, WS_XR); DEFP(float, PART, WS_PART);
        pg8::Gemm g{YC, W_OUT0, MT, DM, DM, DM, DM, 0}; pg8::SplitOrder S; S.init(SEQ, DM, DM, G, bx, 32, S_OUT0);
        pg8::EpiRes E{p.in[0], p.in[2], MOD(0, 0, 2), MOD(0, 1, 2), XR, PART};
        pg8::gemm_phase<pg8::EpiRes, pg8::SplitOrder, true, true>(lds, g, S, E, tid);
    }
    GRID_BAR();

    {
        PHASE_BEGIN(); DEFP(bf16_t, XN, WS_XN); DEFP(float, XR, WS_XR); DEFP(float, PART, WS_PART);
        for (int r = gw; r < MT; r += NGW) {
            if (r < CTX) { const int row = SEQ + r;
                norm_mod_row_parts(p.in[2] + (size_t)r * DM, MOD(0, 1, 2), PART + (size_t)r * DM, S_OUT0, XR + (size_t)row * DM, MOD(0, 1, 3), MOD(0, 1, 4), XN + (size_t)row * DM, lane);
            } else { const int row = r - CTX; norm_mod_row(XR + (size_t)row * DM, MOD(0, 0, 3), MOD(0, 0, 4), XN + (size_t)row * DM, lane); }
        }
    }
    GRID_BAR();

    {
        PHASE_BEGIN(); DEFP(bf16_t, XN, WS_XN); DEFP(bf16_t, W_UP0, WS_WUP0); DEFP(bf16_t, H, WS_R);
        pg8::Gemm g{XN, W_UP0, MT, DFF, DM, DM, DM, 0}; pg8::StaticOrder S; S.init(MT, DFF, DM, G, bx);
        pg8::EpiBf16<1, false> E{H, DFF, 0, nullptr};
        pg8::gemm_phase<pg8::EpiBf16<1, false>, pg8::StaticOrder, true, true>(lds, g, S, E, tid);
    }
    GRID_BAR();

    {
        PHASE_BEGIN(); DEFP(bf16_t, H, WS_R); DEFP(bf16_t, W_DN0, WS_WDN0); DEFP(float, XR, WS_XR); DEFP(float, PART, WS_PART);
        pg8::Gemm g{H, W_DN0, MT, DM, DFF, DFF, DFF, 0}; pg8::SplitOrder S; S.init(SEQ, DM, DFF, G, bx, 32, S_DN0);
        pg8::EpiRes E{XR, XR + (size_t)SEQ * DM, MOD(0, 0, 5), MOD(0, 1, 5), XR, PART};
        pg8::gemm_phase<pg8::EpiRes, pg8::SplitOrder, true, true>(lds, g, S, E, tid);
    }
    GRID_BAR();

    {
        PHASE_BEGIN(); DEFP(bf16_t, XN, WS_XN); DEFP(float, XR, WS_XR); DEFP(float, PART, WS_PART);
        for (int r = gw; r < MT; r += NGW) {
            if (r < CTX) { const int row = SEQ + r;
                norm_mod_row_parts(XR + (size_t)row * DM, MOD(0, 1, 5), PART + (size_t)r * DM, S_DN0, XR + (size_t)row * DM, MOD(1, 1, 0), MOD(1, 1, 1), XN + (size_t)row * DM, lane);
            } else { const int row = r - CTX; norm_mod_row(XR + (size_t)row * DM, MOD(1, 0, 0), MOD(1, 0, 1), XN + (size_t)row * DM, lane); }
        }
    }
    GRID_BAR();

    {
        PHASE_BEGIN(); DEFP(bf16_t, XN, WS_XN); DEFP(bf16_t, W_QKV1, WS_WQKV1); DEFP(float, QKVRAW, WS_QKVRAW);
        pg8::Gemm g{XN, W_QKV1, MT, DIN, DM, DM, DM, 0}; pg8::StaticOrder S; S.init(MT, DIN, DM, G, bx);
        pg8::EpiF32 E{QKVRAW, DIN};
        pg8::gemm_phase<pg8::EpiF32, pg8::StaticOrder, true, true>(lds, g, S, E, tid);
    }
    GRID_BAR();

    {
        PHASE_BEGIN(); DEFP(float, QKVRAW, WS_QKVRAW); DEFP(bf16_t, Qb, WS_Q); DEFP(bf16_t, Kb, WS_K); DEFP(bf16_t, Vb, WS_V);
        const int l31 = lane & 31, hsel = lane >> 5, d0 = 4 * l31, axis = l31 >> 4; const bool second = (l31 & 8) != 0;
        float freq[4];
#pragma unroll
        for (int c = 0; c < 4; ++c) freq[c] = exp2f(-(float)(((d0 & 31) + c)) * (13.287712379549449f / 32.0f));
        const f32x4 qg = *(const f32x4*)(p.in[19] + d0), kg = *(const f32x4*)(p.in[20] + d0);
        for (int row = gw; row < MT; row += NGW) {
            const bool isc = row >= SEQ; const f32x4* src = (const f32x4*)(QKVRAW + (size_t)row * DIN) + lane;
            f32x4 v[12];
#pragma unroll
            for (int j = 0; j < 12; ++j) v[j] = src[64 * j];
            f32x4 cs = {1.f, 1.f, 1.f, 1.f}, sn = {0.f, 0.f, 0.f, 0.f};
            if (!isc) { const float pos = (float)(axis == 0 ? (row >> 6) : (row & 63));
#pragma unroll
                for (int c = 0; c < 4; ++c) { const float ang = pos * freq[c]; cs[c] = cosf(ang); sn[c] = sinf(ang); } }
            const int krow = isc ? row - SEQ : CTX + row;
#pragma unroll
            for (int j = 0; j < 10; ++j) {
                if (j < 8 && isc) continue;
                float ss = (v[j].x * v[j].x + v[j].y * v[j].y) + (v[j].z * v[j].z + v[j].w * v[j].w);
#pragma unroll
                for (int o = 1; o < 32; o <<= 1) ss += __shfl_xor(ss, o);
                const float rstd = 1.0f / sqrtf(ss * (1.f / 128.f) + EPS);
                const f32x4 y = v[j] * rstd * (j < 8 ? qg : kg);
                f32x4 pr; pr.x = __shfl_xor(y.x, 8); pr.y = __shfl_xor(y.y, 8); pr.z = __shfl_xor(y.z, 8); pr.w = __shfl_xor(y.w, 8);
                const f32x4 o4 = second ? (pr * sn + y * cs) : (y * cs - pr * sn);
                u32x2 w; w.x = cvt_pk_bf16(o4.x, o4.y); w.y = cvt_pk_bf16(o4.z, o4.w);
                if (j < 8) *(u32x2*)(Qb + (size_t)row * DM + (2 * j + hsel) * 128 + d0) = w;
                else *(u32x2*)(Kb + (size_t)krow * 512 + (2 * (j - 8) + hsel) * 128 + d0) = w;
            }
#pragma unroll
            for (int j = 10; j < 12; ++j) { u32x2 w; w.x = cvt_pk_bf16(v[j].x, v[j].y); w.y = cvt_pk_bf16(v[j].z, v[j].w);
                *(u32x2*)(Vb + (size_t)krow * 512 + (2 * (j - 10) + hsel) * 128 + d0) = w; }
        }
    }
    GRID_BAR();

    {
        PHASE_BEGIN(); DEFP(bf16_t, Qb, WS_Q); DEFP(bf16_t, Kb, WS_K); DEFP(bf16_t, Vb, WS_V); DEFP(bf16_t, Ob, WS_O);
        const int vcu = (G % 8 == 0) ? (bx % 8) * (G / 8) + bx / 8 : bx;
        for (int uidx = vcu; uidx < 16 * 32; uidx += G) {
            const int h = uidx >> 5, qb = uidx & 31, kvh = h >> 2;
            att::attn_dense_body((const att::bf16*)Qb + (size_t)qb * 256 * DM + h * 128, (const att::bf16*)Kb + kvh * 128, (const att::bf16*)Vb + kvh * 128,
                                 (att::bf16*)Ob + (size_t)qb * 256 * DM + h * 128, MT, (char*)lds_raw, tid);
        }
    }
    GRID_BAR();

    {
        PHASE_BEGIN(); DEFP(bf16_t, Ob, WS_O); DEFP(bf16_t, W_OUT1, WS_WOUT1); DEFP(float, XR, WS_XR);
        pg8::Gemm g{Ob, W_OUT1, SEQ, DM, DM, DM, DM, 0}; pg8::StaticOrder S; S.init(SEQ, DM, DM, G, bx);
        pg8::EpiRes E{XR, XR, MOD(1, 0, 2), MOD(1, 0, 2), XR, nullptr};
        pg8::gemm_phase<pg8::EpiRes, pg8::StaticOrder, true, true>(lds, g, S, E, tid);
    }
    GRID_BAR();

    {
        PHASE_BEGIN(); DEFP(bf16_t, XN, WS_XN); DEFP(float, XR, WS_XR);
        for (int row = gw; row < SEQ; row += NGW) norm_mod_row(XR + (size_t)row * DM, MOD(1, 0, 3), MOD(1, 0, 4), XN + (size_t)row * DM, lane);
    }
    GRID_BAR();

    {
        PHASE_BEGIN(); DEFP(bf16_t, XN, WS_XN); DEFP(bf16_t, W_UP1, WS_WUP1); DEFP(bf16_t, H, WS_R);
        pg8::Gemm g{XN, W_UP1, SEQ, DFF, DM, DM, DM, 0}; pg8::StaticOrder S; S.init(SEQ, DFF, DM, G, bx);
        pg8::EpiBf16<1, false> E{H, DFF, 0, nullptr};
        pg8::gemm_phase<pg8::EpiBf16<1, false>, pg8::StaticOrder, true, true>(lds, g, S, E, tid);
    }
    GRID_BAR();

    {
        PHASE_BEGIN(); DEFP(bf16_t, H, WS_R); DEFP(bf16_t, W_DN1, WS_WDN1); DEFP(float, XR, WS_XR);
        pg8::Gemm g{H, W_DN1, SEQ, DM, DFF, DFF, DFF, 0}; pg8::StaticOrder S; S.init(SEQ, DM, DFF, G, bx);
        pg8::EpiRes E{XR, XR, MOD(1, 0, 5), MOD(1, 0, 5), XR, nullptr};
        pg8::gemm_phase<pg8::EpiRes, pg8::StaticOrder, true, true>(lds, g, S, E, tid);
    }
    GRID_BAR();

    {
        PHASE_BEGIN(); DEFP(float, XR, WS_XR);
        for (int row = gw; row < SEQ; row += NGW) {
            const f32x4* xr = (const f32x4*)(XR + (size_t)row * DM) + lane; f32x4 v[8]; float s = 0.f;
#pragma unroll
            for (int j = 0; j < 8; ++j) { v[j] = xr[64 * j]; s += (v[j].x * v[j].x + v[j].y * v[j].y) + (v[j].z * v[j].z + v[j].w * v[j].w); }
            const float rstd = 1.0f / sqrtf(wave_sum(s) * (1.f / DM) + EPS);
            f32x4* o = (f32x4*)(p.out + (size_t)row * DM) + lane;
#pragma unroll
            for (int j = 0; j < 8; ++j) o[64 * j] = v[j] * rstd * ((const f32x4*)p.in[24])[lane + 64 * j];
        }
    }
#undef MOD
#undef GRID_BAR
}

extern "C" void kernel_launch(void* const* d_in, const int* in_sizes, int n_in, void* d_out, int out_size, void* d_ws, size_t ws_size, hipStream_t stream) {
    static int grid = 0;
    if (grid == 0) {
        if (n_in != 25 || ws_size < WS_END) { fprintf(stderr, "kernel_launch: n_in %d ws %zu (need 25, >= %zu)\n", n_in, ws_size, (size_t)WS_END); }
        int dev = 0, cus = 0, per_cu = 0;
        hipGetDevice(&dev);
        hipDeviceGetAttribute(&cus, hipDeviceAttributeMultiprocessorCount, dev);
        hipFuncSetAttribute((const void*)fwd_mega, hipFuncAttributeMaxDynamicSharedMemorySize, LDS_BYTES);
        hipOccupancyMaxActiveBlocksPerMultiprocessor(&per_cu, (const void*)fwd_mega, 512, LDS_BYTES);
        (void)hipGetLastError();
        if (per_cu < 1) { fprintf(stderr, "kernel_launch: occupancy query says %d blocks per CU\n", per_cu); per_cu = 1; }
        grid = cus;
    }
    (void)hipMemsetAsync(d_ws, 0, WS_CTL_BYTES, stream);
    Params p{};
    for (int i = 0; i < 25; ++i) p.in[i] = (const float*)d_in[i];
    p.out = (float*)d_out; p.ws = (unsigned char*)d_ws;
    void* args[] = {&p};
    hipError_t e = hipLaunchCooperativeKernel((const void*)fwd_mega, dim3(grid), dim3(512), args, LDS_BYTES, stream);
    if (e != hipSuccess) fprintf(stderr, "cooperative launch failed: %s (grid %d)\n", hipGetErrorString(e), grid);
}
```

```cpp
#include <hip/hip_runtime.h>
#include <hip/hip_cooperative_groups.h>
#include <hip/hip_bf16.h>
#include <cstdio>
#include <cstdint>
namespace cg = cooperative_groups;

#define LAS __attribute__((address_space(3)))
typedef unsigned short bf16_t;
typedef short bf16x8 __attribute__((ext_vector_type(8)));
typedef short s16x4 __attribute__((ext_vector_type(4)));
typedef float f32x4 __attribute__((ext_vector_type(4)));
typedef float f32x2 __attribute__((ext_vector_type(2)));
typedef float f32x16 __attribute__((ext_vector_type(16)));
typedef unsigned u32x4 __attribute__((ext_vector_type(4)));
typedef unsigned u32x2 __attribute__((ext_vector_type(2)));

constexpr int DM = 2048, SEQ = 8192, CTX = 256, MT = SEQ + CTX  , DFF = 8192, DIN = 3072;
constexpr int NMODV = 6 * DM;
constexpr float EPS = 1e-6f;

constexpr size_t MiB = 1u << 20;
constexpr size_t WS_BAR = 65536, WS_CTL_BYTES = 262144;
constexpr size_t WS_MODS = 1 * MiB;
constexpr size_t WS_WIN0 = 2 * MiB, WS_WOUT0 = 14 * MiB, WS_WUP0 = 22 * MiB, WS_WDN0 = 54 * MiB;
constexpr size_t WS_WQKV1 = 86 * MiB, WS_WOUT1 = 98 * MiB, WS_WUP1 = 106 * MiB, WS_WDN1 = 138 * MiB, WS_WPOOL = 170 * MiB;
constexpr size_t WS_XR = 172 * MiB;
constexpr size_t WS_XN = 238 * MiB;
constexpr size_t WS_R = 272 * MiB;
constexpr size_t WS_GLU = WS_R, WS_U = WS_R + 33 * MiB, WS_YC = WS_R + 66 * MiB, WS_D = WS_R + 99 * MiB;
constexpr size_t WS_Q = WS_R, WS_K = WS_R + 32 * MiB, WS_V = WS_R + 41 * MiB, WS_O = WS_R + 50 * MiB;
constexpr size_t WS_QKVRAW = 404 * MiB;
constexpr size_t WS_PART = WS_QKVRAW;
constexpr size_t WS_END = 504 * MiB;
constexpr int S_OUT0 = 8, S_DN0 = 16;

constexpr int LDS_BYTES = 147456;

__device__ __forceinline__ unsigned cvt_pk_bf16(float lo, float hi) { unsigned r; asm volatile("v_cvt_pk_bf16_f32 %0, %1, %2" : "=v"(r) : "v"(lo), "v"(hi)); return r; }
__device__ __forceinline__ float wave_sum(float v) {
#pragma unroll
    for (int o = 1; o < 64; o <<= 1) v += __shfl_xor(v, o);
    return v;
}
__device__ __forceinline__ float sigmoidf_(float g) { return 1.0f / (1.0f + __expf(-g)); }

namespace pg8 {
constexpr int BM = 256, BK = 64, HALF = 128, HTB = HALF * BK * 2, STAGE_BYTES = 8 * HTB, NXCD = 8, WGM = 8;
__host__ __device__ __forceinline__ int lds_byte(int r, int c) { const int st = (r >> 4) * 2 + (c >> 5), rr = r & 15, cc = c & 31, ob = rr * 64 + cc * 2; return st * 1024 + (ob ^ (((ob >> 9) & 1) << 5)); }
__host__ __device__ __forceinline__ void stage_rc(int b, int& R, int& C) { const int st = b / 1024, sb = b % 1024, swz = sb ^ (((sb >> 9) & 1) << 5); R = (st >> 1) * 16 + swz / 64; C = (st & 1) * 32 + (swz % 64) / 2; }
__host__ __device__ __forceinline__ int perm32(int rho) { const int n = rho >> 4, i = rho & 15; return 8 * (i >> 2) + 4 * n + (i & 3); }

struct Unit { int pm, pn, koff, nt, sub; };
struct Gemm { const bf16_t* A; const bf16_t* Bt; int M, N, K, lda, ldb, a_pn_off; };

struct StaticOrder {
    int nM, nN, nwg, G, c, ntFull;
    __host__ __device__ void init(int M, int N, int K, int G_, int c_) { nM = M / BM; nN = N / BM; nwg = nM * nN; G = G_; c = c_; ntFull = K / BK; }
    __device__ __forceinline__ void tile(int L, int& pm, int& pn) const {
        int wgid = L; { const int q = nwg / NXCD, r = nwg % NXCD, xcd = wgid % NXCD, off = wgid / NXCD; wgid = (xcd < r ? xcd * (q + 1) : r * (q + 1) + (xcd - r) * q) + off; }
        const int nig = WGM * nN, gid = wgid / nig, fm = gid * WGM, gsz = (nM - fm) < WGM ? (nM - fm) : WGM;
        pm = fm + ((wgid % nig) % gsz); pn = (wgid % nig) / gsz;
    }
    __device__ __forceinline__ bool next(int i, Unit& u) const {
        const int L = i * G + c; const bool ok = L < nwg; int pm, pn; tile(ok ? L : 0, pm, pn);
        u.pm = pm; u.pn = pn; u.koff = 0; u.nt = ntFull; u.sub = -1; return ok;
    }
};
struct SplitOrder {
    StaticOrder main; int nMine, pmSub, S, ntSub, nSub;
    __host__ __device__ void init(int M, int N, int K, int G_, int c_, int pmSub_, int S_) { main.init(M, N, K, G_, c_); nMine = c_ < main.nwg ? (main.nwg - c_ + G_ - 1) / G_ : 0; pmSub = pmSub_; S = S_; ntSub = K / BK / S_; nSub = (N / BM) * S_; }
    __device__ __forceinline__ bool next(int i, Unit& u) const {
        const bool ismain = i < nMine;
        int pm, pn; main.tile(ismain ? i * main.G + main.c : 0, pm, pn);
        const int j = (i - nMine) * main.G + main.c; const int sl = j % S;
        u.pm = ismain ? pm : pmSub; u.pn = ismain ? pn : j / S; u.koff = ismain ? 0 : sl * ntSub * BK; u.nt = ismain ? main.ntFull : ntSub; u.sub = ismain ? -1 : sl;
        return ismain || j < nSub;
    }
};

typedef f32x4 Acc[2][2][4][2];

template <int ACT, bool HAS_SCALE> struct EpiBf16 {
    static constexpr bool PERM = true;
    bf16_t* O; int ldc; int col_off; const float* scale;
    __device__ __forceinline__ void operator()(const Acc& acc, const Unit& u, int wr, int wc, int fr, int fq) const {
        const int row0 = u.pm * BM + wr * 64 + fr; const int col0 = u.pn * BM + wc * 32 + 8 * fq;
        f32x4 sv[2][2];
        if constexpr (HAS_SCALE) {
#pragma unroll
        for (int bj = 0; bj < 2; ++bj)
#pragma unroll
            for (int n = 0; n < 2; ++n) sv[bj][n] = *(const f32x4*)(scale + col0 + bj * HALF + 4 * n);
        }
#pragma unroll
        for (int ai = 0; ai < 2; ++ai)
#pragma unroll
            for (int m = 0; m < 4; ++m) { bf16_t* rowp = O + (size_t)(row0 + ai * HALF + m * 16) * ldc + col_off + col0;
#pragma unroll
                for (int bj = 0; bj < 2; ++bj) { f32x4 v0 = acc[ai][bj][m][0], v1 = acc[ai][bj][m][1];
                    if (ACT == 1) { v0 = __builtin_elementwise_max(v0, (f32x4){0.f, 0.f, 0.f, 0.f}); v1 = __builtin_elementwise_max(v1, (f32x4){0.f, 0.f, 0.f, 0.f}); v0 = v0 * v0; v1 = v1 * v1; }
                    if constexpr (HAS_SCALE) { v0 = v0 * sv[bj][0]; v1 = v1 * sv[bj][1]; }
                    u32x4 w; w.x = cvt_pk_bf16(v0[0], v0[1]); w.y = cvt_pk_bf16(v0[2], v0[3]); w.z = cvt_pk_bf16(v1[0], v1[1]); w.w = cvt_pk_bf16(v1[2], v1[3]);
                    *(u32x4*)(rowp + bj * HALF) = w; } }
    }
};
struct EpiF32 {
    static constexpr bool PERM = false;
    float* O; int ldc;
    __device__ __forceinline__ void operator()(const Acc& acc, const Unit& u, int wr, int wc, int fr, int fq) const {
        const int row0 = u.pm * BM + wr * 64 + fr; const int col0 = u.pn * BM + wc * 32 + 4 * fq;
#pragma unroll
        for (int ai = 0; ai < 2; ++ai)
#pragma unroll
            for (int m = 0; m < 4; ++m) { float* rowp = O + (size_t)(row0 + ai * HALF + m * 16) * ldc + col0;
#pragma unroll
                for (int bj = 0; bj < 2; ++bj)
#pragma unroll
                    for (int n = 0; n < 2; ++n) *(f32x4*)(rowp + bj * HALF + n * 16) = acc[ai][bj][m][n]; }
    }
};
struct EpiGlu {
    static constexpr bool PERM = false;
    float* GLU; float* U;
    __device__ __forceinline__ void operator()(const Acc& acc, const Unit& u, int wr, int wc, int fr, int fq) const {
        const int row0 = u.pm * BM + wr * 64 + fr;
        if (u.pn < 8) {
            const int col0 = u.pn * 128 + wc * 32 + 4 * fq;
#pragma unroll
            for (int ai = 0; ai < 2; ++ai)
#pragma unroll
                for (int m = 0; m < 4; ++m) { float* rowp = GLU + (size_t)(row0 + ai * HALF + m * 16) * 1024 + col0;
#pragma unroll
                    for (int n = 0; n < 2; ++n) { const f32x4 a = acc[ai][0][m][n], g = acc[ai][1][m][n]; f32x4 o;
                        o[0] = a[0] * sigmoidf_(g[0]); o[1] = a[1] * sigmoidf_(g[1]); o[2] = a[2] * sigmoidf_(g[2]); o[3] = a[3] * sigmoidf_(g[3]);
                        *(f32x4*)(rowp + n * 16) = o; } }
        } else {
            const int col0 = (u.pn - 8) * BM + wc * 32 + 4 * fq;
#pragma unroll
            for (int ai = 0; ai < 2; ++ai)
#pragma unroll
                for (int m = 0; m < 4; ++m) { float* rowp = U + (size_t)(row0 + ai * HALF + m * 16) * 1024 + col0;
#pragma unroll
                    for (int bj = 0; bj < 2; ++bj)
#pragma unroll
                        for (int n = 0; n < 2; ++n) *(f32x4*)(rowp + bj * HALF + n * 16) = acc[ai][bj][m][n]; }
        }
    }
};
struct EpiRes {
    static constexpr bool PERM = false;
    const float* baseL; const float* baseC; const float* gateL; const float* gateC; float* out;
    float* part;
    __device__ __forceinline__ void operator()(const Acc& acc, const Unit& u, int wr, int wc, int fr, int fq) const {
        if (u.sub >= 0) {
            float* pp = part + ((size_t)u.sub * BM + wr * 64 + fr) * DM + u.pn * BM + wc * 32 + 4 * fq;
#pragma unroll
            for (int ai = 0; ai < 2; ++ai)
#pragma unroll
                for (int m = 0; m < 4; ++m)
#pragma unroll
                    for (int bj = 0; bj < 2; ++bj)
#pragma unroll
                        for (int n = 0; n < 2; ++n) *(f32x4*)(pp + (size_t)(ai * HALF + m * 16) * DM + bj * HALF + n * 16) = acc[ai][bj][m][n];
            return;
        }
        const bool isc = u.pm >= 32;
        const int row0 = u.pm * BM + wr * 64 + fr; const int col0 = u.pn * BM + wc * 32 + 4 * fq;
        const float* gate = isc ? gateC : gateL;
        const float* base = isc ? baseC + (size_t)(row0 - SEQ) * DM : baseL + (size_t)row0 * DM;
        f32x4 gv[2][2];
#pragma unroll
        for (int bj = 0; bj < 2; ++bj)
#pragma unroll
            for (int n = 0; n < 2; ++n) gv[bj][n] = *(const f32x4*)(gate + col0 + bj * HALF + n * 16);
#pragma unroll
        for (int ai = 0; ai < 2; ++ai)
#pragma unroll
            for (int m = 0; m < 4; ++m) { const size_t ro = (size_t)(ai * HALF + m * 16) * DM + col0; float* op = out + (size_t)row0 * DM + ro;
#pragma unroll
                for (int bj = 0; bj < 2; ++bj)
#pragma unroll
                    for (int n = 0; n < 2; ++n) { const f32x4 b = *(const f32x4*)(base + ro + bj * HALF + n * 16);
                        *(f32x4*)(op + bj * HALF + n * 16) = b + gv[bj][n] * acc[ai][bj][m][n]; } }
    }
};

template <class Epi, class Sched, bool ALIGN_EPI, bool SP2>
__device__ __forceinline__ void gemm_phase(LAS unsigned char* lds, const Gemm g, const Sched& S, const Epi& E, const int tid) {
    const int wid = __builtin_amdgcn_readfirstlane(tid >> 6), lane = tid & 63, wr = wid >> 2, wc = wid & 3, fr = lane & 15, fq = lane >> 4;
    unsigned voffA[2], voffB[2];
#pragma unroll
    for (int i = 0; i < 2; ++i) { int R, C; stage_rc(tid * 16 + i * 8192, R, C); const int Rb = Epi::PERM ? ((R & ~31) + perm32(R & 31)) : R;
        voffA[i] = (unsigned)(R * g.lda + C) * 2u; voffB[i] = (unsigned)(Rb * g.ldb + C) * 2u; }
    const size_t kstep = (size_t)(BK * 2);
    const size_t hstepA = (size_t)HALF * g.lda * 2, hstepB = (size_t)HALF * g.ldb * 2;
    const unsigned ldsw = (unsigned)wid * 1024u;
    const int aoff = lds_byte(wr * 64 + fr, fq * 8), boff = lds_byte(wc * 32 + fr, fq * 8);
#define PG8_UA(u_) ((const char*)g.A + ((size_t)(u_).pm * BM * g.lda + (size_t)(u_).pn * g.a_pn_off + (u_).koff) * 2)
#define PG8_UB(u_) ((const char*)g.Bt + ((size_t)(u_).pn * BM * g.ldb + (u_).koff) * 2)
#define PG8_SA(b, h) (((b) * 2 + (h)) * HTB)
#define PG8_SB(b, h) ((4 + (b) * 2 + (h)) * HTB)
#define PG8_STAGE(bufoff, gbase, voff) do { _Pragma("unroll") for (int _i = 0; _i < 2; ++_i) \
        __builtin_amdgcn_global_load_lds((const unsigned*)((const char*)(gbase) + (voff)[_i]), (LAS unsigned*)(lds + (bufoff) + ldsw + _i * 8192), 16, 0, 0); } while (0)
#define PG8_LDA(dst, b, h) do { _Pragma("unroll") for (int m = 0; m < 4; ++m) _Pragma("unroll") for (int k = 0; k < 2; ++k) dst[m][k] = *(const LAS bf16x8*)(lds + PG8_SA(b, h) + aoff + m * 2048 + k * 1024); } while (0)
#define PG8_LDB(dst, b, h) do { _Pragma("unroll") for (int n = 0; n < 2; ++n) _Pragma("unroll") for (int k = 0; k < 2; ++k) dst[n][k] = *(const LAS bf16x8*)(lds + PG8_SB(b, h) + boff + n * 2048 + k * 1024); } while (0)
#define PG8_MMA(ai, bj, At, Bt) do { __builtin_amdgcn_s_setprio(1); _Pragma("unroll") for (int m = 0; m < 4; ++m) _Pragma("unroll") for (int n = 0; n < 2; ++n) _Pragma("unroll") for (int k = 0; k < 2; ++k) \
        acc[ai][bj][m][n] = __builtin_amdgcn_mfma_f32_16x16x32_bf16(Bt[n][k], At[m][k], acc[ai][bj][m][n], 0, 0, 0); __builtin_amdgcn_s_setprio(0); } while (0)
#define PG8_WAIT_V(n) asm volatile("s_waitcnt vmcnt(" #n ")" ::: "memory")
#define PG8_WAIT_L(n) asm volatile("s_waitcnt lgkmcnt(" #n ")" ::: "memory")
#define PG8_BAR __builtin_amdgcn_s_barrier()
#define PG8_SCHED __builtin_amdgcn_sched_barrier(0)
    Unit cur, nxt; int ui = 0;
    if (!S.next(0, cur)) return;
    f32x4 acc[2][2][4][2];
#pragma unroll
    for (int a = 0; a < 2; ++a)
#pragma unroll
        for (int b = 0; b < 2; ++b)
#pragma unroll
            for (int m = 0; m < 4; ++m)
#pragma unroll
                for (int n = 0; n < 2; ++n) acc[a][b][m][n] = (f32x4){0.f, 0.f, 0.f, 0.f};
    bf16x8 At[4][2], B0[2][2], B1[2][2];
    const char* cA = PG8_UA(cur); const char* cB = PG8_UB(cur);
    if constexpr (SP2) {
        PG8_STAGE(PG8_SB(0, 0), cB, voffB); PG8_STAGE(PG8_SB(0, 1), cB + hstepB, voffB); PG8_STAGE(PG8_SA(0, 0), cA, voffA); PG8_STAGE(PG8_SA(0, 1), cA + hstepA, voffA);
        if (wr == 1) PG8_BAR;
        PG8_WAIT_V(2); PG8_BAR;
        PG8_STAGE(PG8_SB(1, 0), cB + kstep, voffB); PG8_STAGE(PG8_SA(1, 0), cA + kstep, voffA); PG8_STAGE(PG8_SB(1, 1), cB + hstepB + kstep, voffB);
        PG8_WAIT_V(6); PG8_BAR;
    } else {
        PG8_STAGE(PG8_SB(0, 0), cB, voffB); PG8_STAGE(PG8_SA(0, 0), cA, voffA); PG8_STAGE(PG8_SB(0, 1), cB + hstepB, voffB); PG8_STAGE(PG8_SA(0, 1), cA + hstepA, voffA);
        if (wr == 1) PG8_BAR;
        PG8_WAIT_V(4); PG8_BAR;
        PG8_STAGE(PG8_SB(1, 0), cB + kstep, voffB); PG8_STAGE(PG8_SA(1, 0), cA + kstep, voffA); PG8_STAGE(PG8_SB(1, 1), cB + hstepB + kstep, voffB);
        PG8_WAIT_V(6); PG8_BAR;
    }
    for (;;) {
        const bool has_next = S.next(ui + 1, nxt);
        const char* nA = has_next ? PG8_UA(nxt) : cA; const char* nB = has_next ? PG8_UB(nxt) : cB;
        const int nt = cur.nt;
        for (int t = 0; t < nt; t += 2) {
            const bool last = (t == nt - 2);
            const char* a1 = cA + (size_t)(t + 1) * kstep;
            const char* a2 = last ? nA : cA + (size_t)(t + 2) * kstep; const char* b2 = last ? nB : cB + (size_t)(t + 2) * kstep;
            const char* a3 = a2 + kstep; const char* b3 = b2 + kstep;
            if constexpr (SP2) {
            PG8_LDB(B0, 0, 0); PG8_LDB(B1, 0, 1); PG8_SCHED; PG8_LDA(At, 0, 0); PG8_STAGE(PG8_SA(1, 1), a1 + hstepA, voffA);
            PG8_WAIT_V(8); PG8_WAIT_L(0); PG8_BAR; PG8_MMA(0, 0, At, B0); PG8_MMA(0, 1, At, B1); PG8_BAR; PG8_SCHED;
            PG8_LDA(At, 0, 1); PG8_STAGE(PG8_SB(0, 0), b2, voffB); PG8_STAGE(PG8_SB(0, 1), b2 + hstepB, voffB); PG8_STAGE(PG8_SA(0, 0), a2, voffA);
            PG8_WAIT_V(8); PG8_WAIT_L(0); PG8_BAR; PG8_MMA(1, 0, At, B0); PG8_MMA(1, 1, At, B1); PG8_BAR; PG8_SCHED;
            PG8_LDB(B0, 1, 0); PG8_LDB(B1, 1, 1); PG8_SCHED; PG8_LDA(At, 1, 0); PG8_STAGE(PG8_SA(0, 1), a2 + hstepA, voffA);
            PG8_WAIT_V(8); PG8_WAIT_L(0); PG8_BAR; PG8_MMA(0, 0, At, B0); PG8_MMA(0, 1, At, B1); PG8_BAR; PG8_SCHED;
            PG8_LDA(At, 1, 1); PG8_STAGE(PG8_SB(1, 0), b3, voffB); PG8_STAGE(PG8_SB(1, 1), b3 + hstepB, voffB); PG8_STAGE(PG8_SA(1, 0), a3, voffA);
            PG8_WAIT_V(8); PG8_WAIT_L(0); PG8_BAR; PG8_MMA(1, 0, At, B0); PG8_MMA(1, 1, At, B1); PG8_BAR; PG8_SCHED;
            } else {
            PG8_LDB(B0, 0, 0); PG8_SCHED; PG8_LDA(At, 0, 0); PG8_STAGE(PG8_SA(1, 1), a1 + hstepA, voffA);
            PG8_WAIT_L(8); PG8_BAR; PG8_WAIT_L(0); PG8_MMA(0, 0, At, B0); PG8_BAR; PG8_SCHED;
            PG8_LDB(B1, 0, 1); PG8_STAGE(PG8_SB(0, 0), b2, voffB);
            PG8_BAR; PG8_WAIT_L(0); PG8_MMA(0, 1, At, B1); PG8_BAR;
            PG8_LDA(At, 0, 1); PG8_STAGE(PG8_SA(0, 0), a2, voffA);
            PG8_BAR; PG8_WAIT_L(0); PG8_MMA(1, 0, At, B0); PG8_BAR; PG8_SCHED;
            PG8_STAGE(PG8_SB(0, 1), b2 + hstepB, voffB);
            PG8_WAIT_V(6); PG8_BAR; PG8_MMA(1, 1, At, B1); PG8_BAR;
            PG8_LDB(B0, 1, 0); PG8_SCHED; PG8_LDA(At, 1, 0); PG8_STAGE(PG8_SA(0, 1), a2 + hstepA, voffA);
            PG8_WAIT_L(8); PG8_BAR; PG8_WAIT_L(0); PG8_MMA(0, 0, At, B0); PG8_BAR; PG8_SCHED;
            PG8_LDB(B1, 1, 1); PG8_STAGE(PG8_SB(1, 0), b3, voffB);
            PG8_BAR; PG8_WAIT_L(0); PG8_MMA(0, 1, At, B1); PG8_BAR;
            PG8_LDA(At, 1, 1); PG8_STAGE(PG8_SA(1, 0), a3, voffA);
            PG8_BAR; PG8_WAIT_L(0); PG8_MMA(1, 0, At, B0); PG8_BAR; PG8_SCHED;
            PG8_STAGE(PG8_SB(1, 1), b3 + hstepB, voffB);
            PG8_WAIT_V(6); PG8_BAR; PG8_MMA(1, 1, At, B1); PG8_BAR;
            }
        }
        if constexpr (ALIGN_EPI) { if (wr == 0) PG8_BAR; }
        E(acc, cur, wr, wc, fr, fq);
        if (!has_next) break;
#pragma unroll
        for (int a = 0; a < 2; ++a)
#pragma unroll
            for (int b = 0; b < 2; ++b)
#pragma unroll
                for (int m = 0; m < 4; ++m)
#pragma unroll
                    for (int n = 0; n < 2; ++n) acc[a][b][m][n] = (f32x4){0.f, 0.f, 0.f, 0.f};
        cur = nxt; cA = nA; cB = nB; ++ui;
        if constexpr (ALIGN_EPI) { if (wr == 1) PG8_BAR; }
    }
    PG8_WAIT_V(0);
    if constexpr (!ALIGN_EPI) { if (wr == 0) PG8_BAR; }
    PG8_BAR;
#undef PG8_UA
#undef PG8_UB
#undef PG8_SA
#undef PG8_SB
#undef PG8_STAGE
#undef PG8_LDA
#undef PG8_LDB
#undef PG8_MMA
#undef PG8_WAIT_V
#undef PG8_WAIT_L
#undef PG8_BAR
#undef PG8_SCHED
}
}

namespace att {
using bf16 = __hip_bfloat16;
constexpr int D = 128, NW = 8, QBLK = 32, KVBLK = 64;
constexpr float SCALE = 0.088388347648318440f;
constexpr float THR = 8.f;
constexpr int LDQ = 2048, LDK = 512, LDO = 2048;
constexpr size_t SHM_V = KVBLK * D * 2, SHM_K = KVBLK * D * 2, SHM_ATTN = 2 * SHM_V + 2 * SHM_K + NW * 64 * 4;
#define KSWZ(row, colB) ((row) * 256 + ((colB) ^ (((row) & 7) << 4)))
#define SBAR() __builtin_amdgcn_sched_barrier(0)
__device__ __forceinline__ int crow(int r, int hi) { return (r & 3) + 8 * (r >> 2) + 4 * hi; }
__device__ __forceinline__ unsigned cvtpk(float lo, float hi) { unsigned r; asm volatile("v_cvt_pk_bf16_f32 %0, %1, %2" : "=v"(r) : "v"(lo), "v"(hi)); return r; }
__device__ __forceinline__ bf16x8 ld8(const bf16* p) { return *reinterpret_cast<const bf16x8*>(p); }

__device__ __forceinline__ void partialSM(f32x16& p0, f32x16& p1, float& m_reg, float& mn, float& alpha) {
  constexpr float C = SCALE * 1.4426950408889634f;
  float pmax = p0[0]; for (int r = 1; r < 16; ++r) pmax = fmaxf(pmax, p0[r]); for (int r = 0; r < 16; ++r) pmax = fmaxf(pmax, p1[r]);
  { auto rr = __builtin_amdgcn_permlane32_swap(__float_as_uint(pmax), __float_as_uint(pmax), false, false);
    pmax = fmaxf(__uint_as_float(rr[0]), __uint_as_float(rr[1])); }
  if (__builtin_expect(__all(pmax - m_reg <= THR / SCALE), 1)) { mn = m_reg; alpha = 1.f; }
  else { mn = fmaxf(m_reg, pmax); alpha = __builtin_amdgcn_exp2f((m_reg - mn) * C); m_reg = mn; }
  float mnC = -mn * C;
  for (int r = 0; r < 16; ++r) p0[r] = fmaf(p0[r], C, mnC); for (int r = 0; r < 16; ++r) p1[r] = fmaf(p1[r], C, mnC);
  for (int r = 0; r < 16; ++r) p0[r] = __builtin_amdgcn_exp2f(p0[r]);
}
__device__ __forceinline__ void finishSM(f32x16& p0, f32x16& p1, float alpha, float& l_reg, bf16x8& pa0, bf16x8& pa1, bf16x8& pa2, bf16x8& pa3) {
  for (int r = 0; r < 16; ++r) p1[r] = __builtin_amdgcn_exp2f(p1[r]);
  float ps = 0; for (int r = 0; r < 16; ++r) ps += p0[r]; for (int r = 0; r < 16; ++r) ps += p1[r];
  { auto rr = __builtin_amdgcn_permlane32_swap(__float_as_uint(ps), __float_as_uint(ps), false, false);
    ps = __uint_as_float(rr[0]) + __uint_as_float(rr[1]); }
  l_reg = l_reg * alpha + ps;
#define PK4(P, BASE, OUT) do { unsigned a0 = cvtpk(P[BASE + 0], P[BASE + 1]), a1 = cvtpk(P[BASE + 2], P[BASE + 3]);   \
    unsigned b0 = cvtpk(P[BASE + 4], P[BASE + 5]), b1 = cvtpk(P[BASE + 6], P[BASE + 7]);                              \
    auto r0 = __builtin_amdgcn_permlane32_swap(a0, b0, false, false); auto r1 = __builtin_amdgcn_permlane32_swap(a1, b1, false, false); \
    u32x4 w = {r0[0], r1[0], r0[1], r1[1]}; OUT = *reinterpret_cast<bf16x8*>(&w); } while (0)
  PK4(p0, 0, pa0); PK4(p0, 8, pa1); PK4(p1, 0, pa2); PK4(p1, 8, pa3);
#undef PK4
}
__device__ __forceinline__ void qkt(f32x16& p0, f32x16& p1, const bf16* Ks, const bf16x8* qr, int r32, int hi) {
  p0 = f32x16{}; p1 = f32x16{};
  for (int d0 = 0; d0 < 8; ++d0) { int cb = (d0 * 16 + hi * 8) * 2;
    bf16x8 b0 = *reinterpret_cast<const bf16x8*>((const char*)Ks + KSWZ(r32, cb));
    bf16x8 b1 = *reinterpret_cast<const bf16x8*>((const char*)Ks + KSWZ(32 + r32, cb));
    p0 = __builtin_amdgcn_mfma_f32_32x32x16_bf16(b0, qr[d0], p0, 0, 0, 0);
    p1 = __builtin_amdgcn_mfma_f32_32x32x16_bf16(b1, qr[d0], p1, 0, 0, 0); }
}
__device__ __forceinline__ int v_st(int k, int c) { const int kk = (k & ~0xC) | ((k & 4) << 1) | ((k & 8) >> 1); return ((kk >> 3) * 4 + (c >> 5)) * 512 + ((kk & 7) * 32 + (c & 31)) * 2; }
__device__ __forceinline__ int v_rd_base(int lane) { return ((lane & 3) << 3) | (((lane >> 2) & 3) << 6) | (((lane >> 4) & 1) << 5) | (((lane >> 5) & 1) << 8); }
constexpr int v_rd_off(int d0, int ks, int half) { return d0 * 512 + ks * 4096 + half * 2048; }
template <int OFF> __device__ __forceinline__ s16x4 tr_read(int vb) {
  s16x4 r; asm volatile("ds_read_b64_tr_b16 %0, %1 offset:%2" : "=&v"(r) : "v"(vb), "i"(OFF) : "memory"); return r;
}
template <int D0> __device__ __forceinline__ void pv_one(f32x16& od, int vb, bf16x8 pa0, bf16x8 pa1, bf16x8 pa2, bf16x8 pa3) {
  const s16x4 l0 = tr_read<v_rd_off(D0, 0, 0)>(vb), h0 = tr_read<v_rd_off(D0, 0, 1)>(vb), l1 = tr_read<v_rd_off(D0, 1, 0)>(vb), h1 = tr_read<v_rd_off(D0, 1, 1)>(vb);
  const s16x4 l2 = tr_read<v_rd_off(D0, 2, 0)>(vb), h2 = tr_read<v_rd_off(D0, 2, 1)>(vb), l3 = tr_read<v_rd_off(D0, 3, 0)>(vb), h3 = tr_read<v_rd_off(D0, 3, 1)>(vb);
  asm volatile("s_waitcnt lgkmcnt(0)" ::: "memory"); SBAR();
#define PK(L, H) (bf16x8){L[0], L[1], L[2], L[3], H[0], H[1], H[2], H[3]}
  od = __builtin_amdgcn_mfma_f32_32x32x16_bf16(pa0, PK(l0, h0), od, 0, 0, 0);
  od = __builtin_amdgcn_mfma_f32_32x32x16_bf16(pa1, PK(l1, h1), od, 0, 0, 0);
  od = __builtin_amdgcn_mfma_f32_32x32x16_bf16(pa2, PK(l2, h2), od, 0, 0, 0);
  od = __builtin_amdgcn_mfma_f32_32x32x16_bf16(pa3, PK(l3, h3), od, 0, 0, 0);
#undef PK
}
__device__ __forceinline__ void pv_d0(f32x16* o, int vb, bf16x8 pa0, bf16x8 pa1, bf16x8 pa2, bf16x8 pa3) {
  pv_one<0>(o[0], vb, pa0, pa1, pa2, pa3); pv_one<1>(o[1], vb, pa0, pa1, pa2, pa3); pv_one<2>(o[2], vb, pa0, pa1, pa2, pa3); pv_one<3>(o[3], vb, pa0, pa1, pa2, pa3);
}

__device__ __forceinline__ void attn_dense_body(const bf16* __restrict__ Qb, const bf16* __restrict__ Kh, const bf16* __restrict__ Vh,
                                                bf16* __restrict__ Ob, int seq, char* lds, const int tid) {
  const int wid = tid >> 6, lane = tid & 63, r32 = lane & 31, hi = lane >> 5;
  bf16* V_lds = (bf16*)lds; bf16* K_lds = (bf16*)(lds + 2 * SHM_V);
  float* ws = (float*)(lds + 2 * SHM_V + 2 * SHM_K) + wid * 64; float* li_l = ws; float* al_l = ws + 32;
  float m_reg = -1e30f, l_reg = 0; f32x16 o[4] = {}; bf16x8 qr[8];
  const bf16* Qw = Qb + (long)(wid * QBLK + r32) * LDQ + hi * 8;
#pragma unroll
  for (int d0 = 0; d0 < 8; ++d0) qr[d0] = ld8(Qw + d0 * 16);
  const int sr = tid >> 4, sc = (tid & 15) * 8, vst0 = v_st(sr, sc), vst1 = v_st(32 + sr, sc);
  const int vb0 = (int)(uintptr_t)V_lds + v_rd_base(lane);
  struct { bf16x8 vs0, vs1, ks0, ks1; } sr_[2];
#define SLOAD(i, k0) do { sr_[i].vs0 = ld8(&Vh[(long)((k0) + sr) * LDK + sc]); sr_[i].vs1 = ld8(&Vh[(long)((k0) + 32 + sr) * LDK + sc]); \
    sr_[i].ks0 = ld8(&Kh[(long)((k0) + sr) * LDK + sc]); sr_[i].ks1 = ld8(&Kh[(long)((k0) + 32 + sr) * LDK + sc]); } while (0)
#define SWRITE(b, i) do { *(bf16x8*)((char*)V_lds + (b) * SHM_V + vst0) = sr_[i].vs0;          \
    *(bf16x8*)((char*)V_lds + (b) * SHM_V + vst1) = sr_[i].vs1; int kc = sc * 2;               \
    *(bf16x8*)((char*)K_lds + (b) * SHM_K + KSWZ(sr, kc)) = sr_[i].ks0;                       \
    *(bf16x8*)((char*)K_lds + (b) * SHM_K + KSWZ(32 + sr, kc)) = sr_[i].ks1; } while (0)
#define SWAIT() asm volatile("s_waitcnt vmcnt(4)" ::: "memory")
#define RESC(a) do { if (__any((a) < 1.f)) { if (hi == 0) al_l[r32] = (a); asm volatile("s_waitcnt lgkmcnt(0)" ::: "memory"); \
    for (int d = 0; d < 4; ++d) for (int r = 0; r < 16; ++r) o[d][r] *= al_l[crow(r, hi)]; } } while (0)
  f32x16 pA0, pA1, pB0, pB1; float mnA, mnB, alA, alB; bf16x8 pa0, pa1, pa2, pa3; const int NT = seq / KVBLK;
  constexpr int SE = 0, SO = 1;
  SLOAD(SE, 0); asm volatile("s_waitcnt vmcnt(0)" ::: "memory"); SWRITE(0, SE); __syncthreads();
  qkt(pA0, pA1, K_lds, qr, r32, hi); partialSM(pA0, pA1, m_reg, mnA, alA);
  SLOAD(SO, KVBLK); if (2 < NT) SLOAD(SE, 2 * KVBLK);
  SWAIT(); SWRITE(1, SO); __syncthreads();
  for (int j = 1; j + 1 < NT; j += 2) {
    SBAR(); qkt(pB0, pB1, (bf16*)((char*)K_lds + SHM_K), qr, r32, hi);
    finishSM(pA0, pA1, alA, l_reg, pa0, pa1, pa2, pa3); SBAR();
    SLOAD(SO, (j + 2) * KVBLK); SBAR();
    pv_d0(o, vb0, pa0, pa1, pa2, pa3); partialSM(pB0, pB1, m_reg, mnB, alB);
    __syncthreads(); SWAIT(); SWRITE(0, SE);
    RESC(alB); __syncthreads();
    SBAR(); qkt(pA0, pA1, K_lds, qr, r32, hi);
    finishSM(pB0, pB1, alB, l_reg, pa0, pa1, pa2, pa3); SBAR();
    if (j + 3 < NT) SLOAD(SE, (j + 3) * KVBLK); SBAR();
    pv_d0(o, vb0 + (int)SHM_V, pa0, pa1, pa2, pa3); partialSM(pA0, pA1, m_reg, mnA, alA);
    __syncthreads(); SWAIT(); SWRITE(1, SO);
    RESC(alA); __syncthreads();
  }
  SBAR(); qkt(pB0, pB1, (bf16*)((char*)K_lds + SHM_K), qr, r32, hi);
  finishSM(pA0, pA1, alA, l_reg, pa0, pa1, pa2, pa3); SBAR();
  pv_d0(o, vb0, pa0, pa1, pa2, pa3); partialSM(pB0, pB1, m_reg, mnB, alB);
  __syncthreads(); RESC(alB);
  finishSM(pB0, pB1, alB, l_reg, pa0, pa1, pa2, pa3); SBAR();
  pv_d0(o, vb0 + (int)SHM_V, pa0, pa1, pa2, pa3);
  if (hi == 0) li_l[r32] = l_reg; asm volatile("s_waitcnt lgkmcnt(0)" ::: "memory");
  float rli[16];
#pragma unroll
  for (int r = 0; r < 16; ++r) rli[r] = __builtin_amdgcn_rcpf(li_l[crow(r, hi)]);
  bf16* Ow = Ob + (long)(wid * QBLK) * LDO;
#pragma unroll
  for (int r = 0; r < 16; ++r) { int orow = crow(r, hi);
    for (int d0 = 0; d0 < 4; ++d0) Ow[(long)orow * LDO + d0 * 32 + r32] = __float2bfloat16(o[d0][r] * rli[r]); }
  __syncthreads();
#undef SLOAD
#undef SWRITE
#undef SWAIT
#undef RESC
}
#undef KSWZ
#undef SBAR
}

#define XB_TMO      128
#define XB_XCNT(j)  (256  + 64 * (j))
#define XB_XSUB(j)  (1280 + 64 * (j))
#define XB_XGEN(j)  (2304 + 64 * (j))
#define XB_TOP      3328
#define XB_TOPGEN   3392
#define XCD_BAR_WORDS 3456
#define XB_SPIN_CAP (1u << 18)
__device__ __forceinline__ unsigned xb_ld(unsigned* p)              { return __hip_atomic_load(p, __ATOMIC_RELAXED, __HIP_MEMORY_SCOPE_AGENT); }
__device__ __forceinline__ unsigned xb_add(unsigned* p, unsigned v) { return __hip_atomic_fetch_add(p, v, __ATOMIC_RELAXED, __HIP_MEMORY_SCOPE_AGENT); }
__device__ __forceinline__ unsigned xb_xcc_id() { return (unsigned)__builtin_amdgcn_s_getreg((3 << 11) | 20) & 0xFu; }
#define XB_SPIN(cond, bar) do { unsigned _sp = 0; while (cond) { __builtin_amdgcn_s_sleep(1); \
    if ((++_sp & 255u) == 0u) { if (xb_ld(&(bar)[XB_TMO])) break; if (_sp > XB_SPIN_CAP) { atomicAdd(&(bar)[XB_TMO], 1u); break; } } } } while (0)
struct XcdBarrier { unsigned* bar; unsigned x; volatile LAS unsigned* st; };
__device__ __forceinline__ XcdBarrier xcd_barrier_post(unsigned* bar, volatile LAS unsigned* st) {
    XcdBarrier b; b.bar = bar; b.x = xb_xcc_id(); b.st = st;
    if (threadIdx.x == 0) (void)xb_add(&bar[XB_XCNT(b.x)], 1u);
    return b;
}
__device__ __forceinline__ void xcd_barrier_complete(unsigned* bar, unsigned x, unsigned& nloc, unsigned& nx) {
    const unsigned G = gridDim.x * gridDim.y * gridDim.z;
    unsigned sum, cnt, mine, sp = 0u;
    for (;;) {
        sum = 0u; cnt = 0u; mine = 0u;
#pragma unroll
        for (unsigned j = 0; j < 16; ++j) { const unsigned c = xb_ld(&bar[XB_XCNT(j)]); sum += c; cnt += (c > 0u) ? 1u : 0u; mine = (j == x) ? c : mine; }
        if (sum == G) break;
        __builtin_amdgcn_s_sleep(1);
        if ((++sp & 255u) == 0u) { if (xb_ld(&bar[XB_TMO])) break; if (sp > XB_SPIN_CAP) { atomicAdd(&bar[XB_TMO], 1u); break; } }
    }
    nloc = mine > 0u ? mine : 1u; nx = cnt > 0u ? cnt : 1u;
}
__device__ __forceinline__ void xcd_barrier(const XcdBarrier& b) {
    asm volatile("s_waitcnt vmcnt(0)" ::: "memory");
    __syncthreads();
    if (threadIdx.x == 0) {
        unsigned* bar = b.bar;
        __builtin_amdgcn_s_waitcnt(0);
        unsigned nloc = b.st[0], nx = b.st[1];
        if (nloc == 0u) { xcd_barrier_complete(bar, b.x, nloc, nx); b.st[0] = nloc; b.st[1] = nx; }
        const unsigned old = xb_add(&bar[XB_XSUB(b.x)], 1u);
        const unsigned gen = old / nloc;
        if (old + 1u == (gen + 1u) * nloc) {
            __builtin_amdgcn_fence(__ATOMIC_RELEASE, "agent");
            asm volatile("s_waitcnt vmcnt(0)" ::: "memory");
            const unsigned og = xb_add(&bar[XB_TOP], 1u);
            const unsigned tg = og / nx;
            if (og + 1u == (tg + 1u) * nx) xb_add(&bar[XB_TOPGEN], 1u);
            else XB_SPIN(xb_ld(&bar[XB_TOPGEN]) == tg, bar);
            __builtin_amdgcn_fence(__ATOMIC_ACQUIRE, "agent");
            xb_add(&bar[XB_XGEN(b.x)], 1u);
            asm volatile("s_waitcnt vmcnt(0)" ::: "memory");
        } else {
            XB_SPIN(xb_ld(&bar[XB_XGEN(b.x)]) == gen, bar);
            __builtin_amdgcn_fence(__ATOMIC_ACQUIRE, "agent");
            asm volatile("s_waitcnt vmcnt(0)" ::: "memory");
        }
    }
    __syncthreads();
}

struct Params { const float* in[25]; float* out; unsigned char* ws; };

constexpr int CI_IN = 32 * 96, CI_OUT = 32 * 64, CI_UP = 32 * 256, CI_DN = 128 * 64, CI_PW = 32;
constexpr int CV_IN0 = 0, CV_POOL = CV_IN0 + CI_IN, CV_OUT0 = CV_POOL + 4 * CI_PW, CV_UP0 = CV_OUT0 + CI_OUT, CV_DN0 = CV_UP0 + CI_UP,
              CV_QKV1 = CV_DN0 + CI_DN, CV_OUT1 = CV_QKV1 + CI_IN, CV_UP1 = CV_OUT1 + CI_OUT, CV_DN1 = CV_UP1 + CI_UP, CV_END = CV_DN1 + CI_DN;
struct CvtMat { const float* W; bf16_t* WT; const float* cs; int K, N, glu; };
__device__ __forceinline__ void cvt_load(const CvtMat& d, int item, int lane, f32x4 (&v)[8]) {
    const int nblk = d.N / 32, kb = item / nblk, nb = item % nblk, k0 = 64 * kb, n0 = 32 * nb, lr = lane >> 3, c4 = (lane & 7) * 4;
#pragma unroll
    for (int i = 0; i < 8; ++i) v[i] = *(const f32x4*)(d.W + (size_t)(k0 + lr + 8 * i) * d.N + n0 + c4);
}
__device__ __forceinline__ void cvt_to_lds(const CvtMat& d, int item, int lane, const f32x4 (&v)[8], LAS float* scr) {
    const int nblk = d.N / 32, nb = item % nblk, n0 = 32 * nb, lr = lane >> 3, c4 = (lane & 7) * 4;
    const f32x4 csc = d.cs ? *(const f32x4*)(d.cs + n0 + c4) : (f32x4){1.f, 1.f, 1.f, 1.f};
#pragma unroll
    for (int i = 0; i < 8; ++i) { LAS float* q = scr + (lr + 8 * i) * 33 + c4; const f32x4 w = v[i] * csc; q[0] = w.x; q[1] = w.y; q[2] = w.z; q[3] = w.w; }
}
__device__ __forceinline__ void cvt_store(const CvtMat& d, int item, int lane, const LAS float* scr) {
    const int nblk = d.N / 32, kb = item / nblk, nb = item % nblk, k0 = 64 * kb, n0 = 32 * nb;
    int r0 = n0;
    if (d.glu && n0 < 2048) { const int half = n0 >> 10, ch = n0 & 1023; r0 = (ch >> 7) * 256 + half * 128 + (ch & 127); }
    const int c = lane & 7;
#pragma unroll
    for (int j = 0; j < 4; ++j) { const int n = (lane >> 3) + 8 * j; const LAS float* sp = scr + (8 * c) * 33 + n;
        u32x4 o; o.x = cvt_pk_bf16(sp[0 * 33], sp[1 * 33]); o.y = cvt_pk_bf16(sp[2 * 33], sp[3 * 33]); o.z = cvt_pk_bf16(sp[4 * 33], sp[5 * 33]); o.w = cvt_pk_bf16(sp[6 * 33], sp[7 * 33]);
        *(u32x4*)(d.WT + (size_t)(r0 + n) * d.K + k0 + 8 * c) = o; }
}
__device__ __forceinline__ void cvt_matrix(const CvtMat& d, int nitems, int off, int widx, int wstride, LAS float* scr, int lane) {
    int it = (widx + wstride - (off % wstride)) % wstride; if (it >= nitems) return;
    f32x4 v[8]; cvt_load(d, it, lane, v);
    for (;;) {
        cvt_to_lds(d, it, lane, v, scr);
        const int nx = it + wstride; const bool more = nx < nitems;
        if (more) cvt_load(d, nx, lane, v);
        asm volatile("s_waitcnt lgkmcnt(0)" ::: "memory");
        cvt_store(d, it, lane, scr);
        asm volatile("s_waitcnt lgkmcnt(0)" ::: "memory");
        if (!more) break;
        it = nx;
    }
}
__device__ __forceinline__ void adaln_items(const Params& p, float* MODS, LAS unsigned char* lds, int l, int bidx, int bstride, int tid) {
    LAS float* sS = (LAS float*)lds;
    LAS float* red = (LAS float*)(lds + 16384);
    __syncthreads();
    for (int k = tid; k < DM; k += 512) { const float a = p.in[1][k], b = p.in[3][k]; sS[k] = a / (1.0f + expf(-a)); sS[DM + k] = b / (1.0f + expf(-b)); }
    __syncthreads();
    const int cgi = tid & 7, ks = tid >> 3;
    const float* Wa = l ? p.in[16] : p.in[4]; const float* bvec = l ? p.in[17] : p.in[5];
    for (int item = bidx; item < 384; item += bstride) {
        const int col0 = item * 32;
        f32x4 a0 = {0.f, 0.f, 0.f, 0.f}, a1 = {0.f, 0.f, 0.f, 0.f};
        const float* wp = Wa + (size_t)(ks * 32) * NMODV + col0 + cgi * 4;
#pragma unroll 8
        for (int kk = 0; kk < 32; ++kk) { const f32x4 w = *(const f32x4*)(wp + (size_t)kk * NMODV); const float s0 = sS[ks * 32 + kk], s1 = sS[DM + ks * 32 + kk]; a0 += w * s0; a1 += w * s1; }
        *(LAS f32x4*)(red + (ks * 8 + cgi) * 8) = a0; *(LAS f32x4*)(red + (ks * 8 + cgi) * 8 + 4) = a1;
        __syncthreads();
        if (tid < 64) { float sm = 0.f;
#pragma unroll 8
            for (int q = 0; q < 64; ++q) sm += red[q * 64 + tid];
            const int cnd = (tid >> 2) & 1, colj = (tid >> 3) * 4 + (tid & 3);
            MODS[(l * 2 + cnd) * NMODV + col0 + colj] = sm + bvec[col0 + colj]; }
        __syncthreads();
    }
}

__device__ __forceinline__ void norm_finish(const f32x4 (&v)[8], const float* sh, const float* sc, bf16_t* orow, int lane) {
    float s = 0.f;
#pragma unroll
    for (int j = 0; j < 8; ++j) s += (v[j].x * v[j].x + v[j].y * v[j].y) + (v[j].z * v[j].z + v[j].w * v[j].w);
    const float rstd = 1.0f / sqrtf(wave_sum(s) * (1.f / DM) + EPS);
    u32x2* o8 = (u32x2*)orow + lane;
#pragma unroll
    for (int j = 0; j < 8; ++j) { const f32x4 a = ((const f32x4*)sc)[lane + 64 * j], b = ((const f32x4*)sh)[lane + 64 * j]; const f32x4 y = v[j] * rstd * (a + 1.0f) + b;
        u32x2 w; w.x = cvt_pk_bf16(y.x, y.y); w.y = cvt_pk_bf16(y.z, y.w); o8[64 * j] = w; }
}
__device__ __forceinline__ void norm_mod_row(const float* xrow, const float* sh, const float* sc, bf16_t* orow, int lane) {
    const f32x4* xr = (const f32x4*)xrow + lane; f32x4 v[8];
#pragma unroll
    for (int j = 0; j < 8; ++j) v[j] = xr[64 * j];
    norm_finish(v, sh, sc, orow, lane);
}
__device__ __forceinline__ void norm_mod_row_parts(const float* base, const float* gate, const float* part, int S, float* xout, const float* sh, const float* sc, bf16_t* orow, int lane) {
    f32x4 v[8], a[8];
#pragma unroll
    for (int j = 0; j < 8; ++j) { v[j] = ((const f32x4*)base)[lane + 64 * j]; a[j] = (f32x4){0.f, 0.f, 0.f, 0.f}; }
    for (int sl = 0; sl < S; ++sl) { const f32x4* pp = (const f32x4*)(part + (size_t)sl * 256 * DM) + lane;
#pragma unroll
        for (int j = 0; j < 8; ++j) a[j] += pp[64 * j]; }
#pragma unroll
    for (int j = 0; j < 8; ++j) { v[j] += ((const f32x4*)gate)[lane + 64 * j] * a[j]; ((f32x4*)xout)[lane + 64 * j] = v[j]; }
    norm_finish(v, sh, sc, orow, lane);
}

template <int W> __device__ __forceinline__ void pool_chunk(const float* U, bf16_t* Dd, int row0, int seq_lo, int seq_hi, int ch) {
    f32x2 in[W + 7];
#pragma unroll
    for (int i = 0; i < W + 7; ++i) { const int r = row0 - W / 2 + i; const bool ok = (r >= seq_lo) && (r < seq_hi);
        in[i] = ok ? *(const f32x2*)(U + (size_t)r * 1024 + ch) : (f32x2){0.f, 0.f}; }
#pragma unroll
    for (int o = 0; o < 8; ++o) { f32x2 s = {0.f, 0.f};
#pragma unroll
        for (int j = 0; j < W; ++j) s += in[o + j];
        const int t = row0 + o; const int lo = max(t - W / 2, seq_lo), hi = min(t - W / 2 + W, seq_hi); const float inv = 1.0f / (float)(hi - lo);
        const f32x2 d = s * inv - in[o + W / 2];
        *(unsigned*)(Dd + (size_t)t * 1024 + ch) = cvt_pk_bf16(d.x, d.y); }
}

__global__ void __launch_bounds__(512, 2) fwd_mega(Params p) {
    extern __shared__ __attribute__((aligned(16))) unsigned char lds_raw[];
    cg::grid_group grid = cg::this_grid();
    LAS unsigned char* lds = (LAS unsigned char*)lds_raw;
    const int G = gridDim.x, bx = blockIdx.x;
#define PHASE_BEGIN() int tid = threadIdx.x; asm volatile("" : "+v"(tid)); size_t wz_ = 0; asm volatile("" : "+s"(wz_)); unsigned char* ws = p.ws + wz_; \
    const int lane = tid & 63, wave = __builtin_amdgcn_readfirstlane(tid >> 6); const int gw = bx * 8 + wave, NGW = G * 8; (void)lane; (void)gw; (void)NGW; \
    float* MODS = (float*)(ws + WS_MODS); (void)MODS
#define DEFP(T, name, off) T* name = (T*)(ws + (off))
    volatile LAS unsigned* MISC = (volatile LAS unsigned*)(lds + 131072 + 320);
    if (threadIdx.x < 32) MISC[threadIdx.x] = 0u;
    __syncthreads();
    const XcdBarrier xbar = xcd_barrier_post((unsigned*)(p.ws + WS_BAR), MISC + 8);
#define GRID_BAR() xcd_barrier(xbar)
#define MOD(l, cnd, chunk) (MODS + ((l) * 2 + (cnd)) * NMODV + (chunk) * DM)

    {
        PHASE_BEGIN();
        adaln_items(p, MODS, lds, 0, bx, G, tid);
        LAS float* scr = (LAS float*)(lds + wave * 16384);
        cvt_matrix(CvtMat{p.in[6], (bf16_t*)(ws + WS_WIN0), nullptr, DM, DIN, 1}, CI_IN, 0, gw, NGW, scr, lane);
        for (int g4 = 0; g4 < 4; ++g4) cvt_matrix(CvtMat{p.in[11] + (size_t)g4 * 65536, (bf16_t*)(ws + WS_WPOOL) + (size_t)g4 * 65536, p.in[12] + g4 * 256, 256, 256, 0}, CI_PW, CI_IN + g4 * CI_PW, gw, NGW, scr, lane);
    }
    grid.sync();

    {
        PHASE_BEGIN(); DEFP(bf16_t, XN, WS_XN);
        for (int row = gw; row < MT; row += NGW) {
            const bool isc = row >= SEQ;
            norm_mod_row(isc ? p.in[2] + (size_t)(row - SEQ) * DM : p.in[0] + (size_t)row * DM, MOD(0, isc ? 1 : 0, 0), MOD(0, isc ? 1 : 0, 1), XN + (size_t)row * DM, lane);
        }
    }
    GRID_BAR();

    {
        PHASE_BEGIN(); DEFP(bf16_t, XN, WS_XN); DEFP(bf16_t, W_IN0, WS_WIN0); DEFP(float, GLU, WS_GLU); DEFP(float, U, WS_U);
        pg8::Gemm g{XN, W_IN0, MT, DIN, DM, DM, DM, 0}; pg8::StaticOrder S; S.init(MT, DIN, DM, G, bx);
        pg8::EpiGlu E{GLU, U};
        pg8::gemm_phase<pg8::EpiGlu, pg8::StaticOrder, true, true>(lds, g, S, E, tid);
        { const int first = S.nwg % G; if (bx >= first) { __syncthreads(); LAS float* scr = (LAS float*)(lds + wave * 16384); const int widx = (bx - first) * 8 + wave, wstr = (G - first) * 8;
            cvt_matrix(CvtMat{p.in[13], (bf16_t*)(ws + WS_WOUT0), nullptr, DM, DM, 0}, CI_OUT, 0, widx, wstr, scr, lane);
            cvt_matrix(CvtMat{p.in[14], (bf16_t*)(ws + WS_WUP0), nullptr, DM, DFF, 0}, CI_UP, CI_OUT, widx, wstr, scr, lane); } }
    }
    GRID_BAR();

    {
        PHASE_BEGIN(); DEFP(float, GLU, WS_GLU); DEFP(float, U, WS_U); DEFP(bf16_t, YC, WS_YC); DEFP(bf16_t, Dd, WS_D);
        const int ch = 2 * tid;
        f32x2 cw[31];
#pragma unroll
        for (int j = 0; j < 31; ++j) cw[j] = *(const f32x2*)(p.in[7] + j * 1024 + ch);
        const f32x2 cb = *(const f32x2*)(p.in[8] + ch), lg = *(const f32x2*)(p.in[9] + ch), lb = *(const f32x2*)(p.in[10] + ch);
        LAS float* red1 = (LAS float*)lds; LAS float* red2 = (LAS float*)(lds + 256);
        for (int chunk = bx; chunk < MT / 8; chunk += G) {
            const int row0 = chunk * 8; const int seq_lo = row0 < SEQ ? 0 : SEQ, seq_hi = row0 < SEQ ? SEQ : MT;
            f32x2 acc[8];
#pragma unroll
            for (int o = 0; o < 8; ++o) acc[o] = cb;
#pragma unroll
            for (int i = 0; i < 38; ++i) { const int r = row0 - 15 + i; const bool ok = (r >= seq_lo) && (r < seq_hi);
                const f32x2 xv = ok ? *(const f32x2*)(GLU + (size_t)r * 1024 + ch) : (f32x2){0.f, 0.f};
#pragma unroll
                for (int o = 0; o < 8; ++o) { const int j = i - o; if (j >= 0 && j < 31) acc[o] += xv * cw[j]; } }
            float s[8];
#pragma unroll
            for (int o = 0; o < 8; ++o) s[o] = wave_sum(acc[o].x + acc[o].y);
            if (lane == 0) {
#pragma unroll
                for (int o = 0; o < 8; ++o) red1[wave * 8 + o] = s[o]; }
            __syncthreads();
#pragma unroll
            for (int o = 0; o < 8; ++o) { float t = 0.f;
#pragma unroll
                for (int w = 0; w < 8; ++w) t += red1[w * 8 + o];
                const float mean = t * (1.f / 1024.f); acc[o] = acc[o] - mean; s[o] = wave_sum(acc[o].x * acc[o].x + acc[o].y * acc[o].y); }
            if (lane == 0) {
#pragma unroll
                for (int o = 0; o < 8; ++o) red2[wave * 8 + o] = s[o]; }
            __syncthreads();
#pragma unroll
            for (int o = 0; o < 8; ++o) { float t = 0.f;
#pragma unroll
                for (int w = 0; w < 8; ++w) t += red2[w * 8 + o];
                const float rstd = 1.0f / sqrtf(t * (1.f / 1024.f) + EPS);
                const f32x2 y = acc[o] * rstd * lg + lb;
                const float y0 = y.x * sigmoidf_(y.x), y1 = y.y * sigmoidf_(y.y);
                *(unsigned*)(YC + (size_t)(row0 + o) * DM + ch) = cvt_pk_bf16(y0, y1); }
            const int pg = wave >> 1;
            if (pg == 0) pool_chunk<2>(U, Dd, row0, seq_lo, seq_hi, ch);
            else if (pg == 1) pool_chunk<4>(U, Dd, row0, seq_lo, seq_hi, ch);
            else if (pg == 2) pool_chunk<8>(U, Dd, row0, seq_lo, seq_hi, ch);
            else pool_chunk<16>(U, Dd, row0, seq_lo, seq_hi, ch);
        }
    }
    GRID_BAR();

    {
        PHASE_BEGIN(); DEFP(bf16_t, Dd, WS_D); DEFP(bf16_t, W_POOL, WS_WPOOL); DEFP(bf16_t, YC, WS_YC);
        pg8::Gemm g{Dd, W_POOL, MT, 1024, 256, 1024, 256, 256}; pg8::StaticOrder S; S.init(MT, 1024, 256, G, bx);
        pg8::EpiBf16<0, false> E{YC, DM, 1024, nullptr};
        pg8::gemm_phase<pg8::EpiBf16<0, false>, pg8::StaticOrder, true, true>(lds, g, S, E, tid);
    }
    GRID_BAR();

    {
        PHASE_BEGIN(); DEFP(bf16_t, YC, WS_YC); DEFP(bf16_t, W_OUT0, WS_WOUT0); DEFP(float, XR, WS_XR); DEFP(float, PART, WS_PART);
        pg8::Gemm g{YC, W_OUT0, MT, DM, DM, DM, DM, 0}; pg8::SplitOrder S; S.init(SEQ, DM, DM, G, bx, 32, S_OUT0);
        pg8::EpiRes E{p.in[0], p.in[2], MOD(0, 0, 2), MOD(0, 1, 2), XR, PART};
        pg8::gemm_phase<pg8::EpiRes, pg8::SplitOrder, true, true>(lds, g, S, E, tid);
    }
    GRID_BAR();

    {
        PHASE_BEGIN(); DEFP(bf16_t, XN, WS_XN); DEFP(float, XR, WS_XR); DEFP(float, PART, WS_PART);
        for (int r = gw; r < MT; r += NGW) {
            if (r < CTX) { const int row = SEQ + r;
                norm_mod_row_parts(p.in[2] + (size_t)r * DM, MOD(0, 1, 2), PART + (size_t)r * DM, S_OUT0, XR + (size_t)row * DM, MOD(0, 1, 3), MOD(0, 1, 4), XN + (size_t)row * DM, lane);
            } else { const int row = r - CTX; norm_mod_row(XR + (size_t)row * DM, MOD(0, 0, 3), MOD(0, 0, 4), XN + (size_t)row * DM, lane); }
        }
    }
    GRID_BAR();

    {
        PHASE_BEGIN(); DEFP(bf16_t, XN, WS_XN); DEFP(bf16_t, W_UP0, WS_WUP0); DEFP(bf16_t, H, WS_R);
        pg8::Gemm g{XN, W_UP0, MT, DFF, DM, DM, DM, 0}; pg8::StaticOrder S; S.init(MT, DFF, DM, G, bx);
        pg8::EpiBf16<1, false> E{H, DFF, 0, nullptr};
        pg8::gemm_phase<pg8::EpiBf16<1, false>, pg8::StaticOrder, true, true>(lds, g, S, E, tid);
        { const int first = S.nwg % G; if (bx >= first) { adaln_items(p, MODS, lds, 1, bx - first, G - first, tid); __syncthreads();
            LAS float* scr = (LAS float*)(lds + wave * 16384); const int widx = (bx - first) * 8 + wave, wstr = (G - first) * 8;
            cvt_matrix(CvtMat{p.in[15], (bf16_t*)(ws + WS_WDN0), nullptr, DFF, DM, 0}, CI_DN, 0, widx, wstr, scr, lane);
            cvt_matrix(CvtMat{p.in[18], (bf16_t*)(ws + WS_WQKV1), nullptr, DM, DIN, 0}, CI_IN, CI_DN, widx, wstr, scr, lane);
            cvt_matrix(CvtMat{p.in[21], (bf16_t*)(ws + WS_WOUT1), nullptr, DM, DM, 0}, CI_OUT, CI_DN + CI_IN, widx, wstr, scr, lane); } }
    }
    GRID_BAR();

    {
        PHASE_BEGIN(); DEFP(bf16_t, H, WS_R); DEFP(bf16_t, W_DN0, WS_WDN0); DEFP(float, XR, WS_XR); DEFP(float, PART, WS_PART);
        pg8::Gemm g{H, W_DN0, MT, DM, DFF, DFF, DFF, 0}; pg8::SplitOrder S; S.init(SEQ, DM, DFF, G, bx, 32, S_DN0);
        pg8::EpiRes E{XR, XR + (size_t)SEQ * DM, MOD(0, 0, 5), MOD(0, 1, 5), XR, PART};
        pg8::gemm_phase<pg8::EpiRes, pg8::SplitOrder, true, true>(lds, g, S, E, tid);
    }
    GRID_BAR();

    {
        PHASE_BEGIN(); DEFP(bf16_t, XN, WS_XN); DEFP(float, XR, WS_XR); DEFP(float, PART, WS_PART);
        for (int r = gw; r < MT; r += NGW) {
            if (r < CTX) { const int row = SEQ + r;
                norm_mod_row_parts(XR + (size_t)row * DM, MOD(0, 1, 5), PART + (size_t)r * DM, S_DN0, XR + (size_t)row * DM, MOD(1, 1, 0), MOD(1, 1, 1), XN + (size_t)row * DM, lane);
            } else { const int row = r - CTX; norm_mod_row(XR + (size_t)row * DM, MOD(1, 0, 0), MOD(1, 0, 1), XN + (size_t)row * DM, lane); }
        }
    }
    GRID_BAR();

    {
        PHASE_BEGIN(); DEFP(bf16_t, XN, WS_XN); DEFP(bf16_t, W_QKV1, WS_WQKV1); DEFP(float, QKVRAW, WS_QKVRAW);
        pg8::Gemm g{XN, W_QKV1, MT, DIN, DM, DM, DM, 0}; pg8::StaticOrder S; S.init(MT, DIN, DM, G, bx);
        pg8::EpiF32 E{QKVRAW, DIN};
        pg8::gemm_phase<pg8::EpiF32, pg8::StaticOrder, true, true>(lds, g, S, E, tid);
        { const int first = S.nwg % G; if (bx >= first) { __syncthreads(); LAS float* scr = (LAS float*)(lds + wave * 16384); const int widx = (bx - first) * 8 + wave, wstr = (G - first) * 8;
            cvt_matrix(CvtMat{p.in[22], (bf16_t*)(ws + WS_WUP1), nullptr, DM, DFF, 0}, CI_UP, 0, widx, wstr, scr, lane);
            cvt_matrix(CvtMat{p.in[23], (bf16_t*)(ws + WS_WDN1), nullptr, DFF, DM, 0}, CI_DN, CI_UP, widx, wstr, scr, lane); } }
    }
    GRID_BAR();

    {
        PHASE_BEGIN(); DEFP(float, QKVRAW, WS_QKVRAW); DEFP(bf16_t, Qb, WS_Q); DEFP(bf16_t, Kb, WS_K); DEFP(bf16_t, Vb, WS_V);
        const int l31 = lane & 31, hsel = lane >> 5, d0 = 4 * l31, axis = l31 >> 4; const bool second = (l31 & 8) != 0;
        float freq[4];
#pragma unroll
        for (int c = 0; c < 4; ++c) freq[c] = exp2f(-(float)(((d0 & 31) + c)) * (13.287712379549449f / 32.0f));
        const f32x4 qg = *(const f32x4*)(p.in[19] + d0), kg = *(const f32x4*)(p.in[20] + d0);
        for (int row = gw; row < MT; row += NGW) {
            const bool isc = row >= SEQ; const f32x4* src = (const f32x4*)(QKVRAW + (size_t)row * DIN) + lane;
            f32x4 v[12];
#pragma unroll
            for (int j = 0; j < 12; ++j) v[j] = src[64 * j];
            f32x4 cs = {1.f, 1.f, 1.f, 1.f}, sn = {0.f, 0.f, 0.f, 0.f};
            if (!isc) { const float pos = (float)(axis == 0 ? (row >> 6) : (row & 63));
#pragma unroll
                for (int c = 0; c < 4; ++c) { const float ang = pos * freq[c]; cs[c] = cosf(ang); sn[c] = sinf(ang); } }
            const int krow = isc ? row - SEQ : CTX + row;
#pragma unroll
            for (int j = 0; j < 10; ++j) {
                if (j < 8 && isc) continue;
                float ss = (v[j].x * v[j].x + v[j].y * v[j].y) + (v[j].z * v[j].z + v[j].w * v[j].w);
#pragma unroll
                for (int o = 1; o < 32; o <<= 1) ss += __shfl_xor(ss, o);
                const float rstd = 1.0f / sqrtf(ss * (1.f / 128.f) + EPS);
                const f32x4 y = v[j] * rstd * (j < 8 ? qg : kg);
                f32x4 pr; pr.x = __shfl_xor(y.x, 8); pr.y = __shfl_xor(y.y, 8); pr.z = __shfl_xor(y.z, 8); pr.w = __shfl_xor(y.w, 8);
                const f32x4 o4 = second ? (pr * sn + y * cs) : (y * cs - pr * sn);
                u32x2 w; w.x = cvt_pk_bf16(o4.x, o4.y); w.y = cvt_pk_bf16(o4.z, o4.w);
                if (j < 8) *(u32x2*)(Qb + (size_t)row * DM + (2 * j + hsel) * 128 + d0) = w;
                else *(u32x2*)(Kb + (size_t)krow * 512 + (2 * (j - 8) + hsel) * 128 + d0) = w;
            }
#pragma unroll
            for (int j = 10; j < 12; ++j) { u32x2 w; w.x = cvt_pk_bf16(v[j].x, v[j].y); w.y = cvt_pk_bf16(v[j].z, v[j].w);
                *(u32x2*)(Vb + (size_t)krow * 512 + (2 * (j - 10) + hsel) * 128 + d0) = w; }
        }
    }
    GRID_BAR();

    {
        PHASE_BEGIN(); DEFP(bf16_t, Qb, WS_Q); DEFP(bf16_t, Kb, WS_K); DEFP(bf16_t, Vb, WS_V); DEFP(bf16_t, Ob, WS_O);
        const int vcu = (G % 8 == 0) ? (bx % 8) * (G / 8) + bx / 8 : bx;
        for (int uidx = vcu; uidx < 16 * 32; uidx += G) {
            const int h = uidx >> 5, qb = uidx & 31, kvh = h >> 2;
            att::attn_dense_body((const att::bf16*)Qb + (size_t)qb * 256 * DM + h * 128, (const att::bf16*)Kb + kvh * 128, (const att::bf16*)Vb + kvh * 128,
                                 (att::bf16*)Ob + (size_t)qb * 256 * DM + h * 128, MT, (char*)lds_raw, tid);
        }
    }
    GRID_BAR();

    {
        PHASE_BEGIN(); DEFP(bf16_t, Ob, WS_O); DEFP(bf16_t, W_OUT1, WS_WOUT1); DEFP(float, XR, WS_XR);
        pg8::Gemm g{Ob, W_OUT1, SEQ, DM, DM, DM, DM, 0}; pg8::StaticOrder S; S.init(SEQ, DM, DM, G, bx);
        pg8::EpiRes E{XR, XR, MOD(1, 0, 2), MOD(1, 0, 2), XR, nullptr};
        pg8::gemm_phase<pg8::EpiRes, pg8::StaticOrder, true, true>(lds, g, S, E, tid);
    }
    GRID_BAR();

    {
        PHASE_BEGIN(); DEFP(bf16_t, XN, WS_XN); DEFP(float, XR, WS_XR);
        for (int row = gw; row < SEQ; row += NGW) norm_mod_row(XR + (size_t)row * DM, MOD(1, 0, 3), MOD(1, 0, 4), XN + (size_t)row * DM, lane);
    }
    GRID_BAR();

    {
        PHASE_BEGIN(); DEFP(bf16_t, XN, WS_XN); DEFP(bf16_t, W_UP1, WS_WUP1); DEFP(bf16_t, H, WS_R);
        pg8::Gemm g{XN, W_UP1, SEQ, DFF, DM, DM, DM, 0}; pg8::StaticOrder S; S.init(SEQ, DFF, DM, G, bx);
        pg8::EpiBf16<1, false> E{H, DFF, 0, nullptr};
        pg8::gemm_phase<pg8::EpiBf16<1, false>, pg8::StaticOrder, true, true>(lds, g, S, E, tid);
    }
    GRID_BAR();

    {
        PHASE_BEGIN(); DEFP(bf16_t, H, WS_R); DEFP(bf16_t, W_DN1, WS_WDN1); DEFP(float, XR, WS_XR);
        pg8::Gemm g{H, W_DN1, SEQ, DM, DFF, DFF, DFF, 0}; pg8::StaticOrder S; S.init(SEQ, DM, DFF, G, bx);
        pg8::EpiRes E{XR, XR, MOD(1, 0, 5), MOD(1, 0, 5), XR, nullptr};
        pg8::gemm_phase<pg8::EpiRes, pg8::StaticOrder, true, true>(lds, g, S, E, tid);
    }
    GRID_BAR();

    {
        PHASE_BEGIN(); DEFP(float, XR, WS_XR);
        for (int row = gw; row < SEQ; row += NGW) {
            const f32x4* xr = (const f32x4*)(XR + (size_t)row * DM) + lane; f32x4 v[8]; float s = 0.f;
#pragma unroll
            for (int j = 0; j < 8; ++j) { v[j] = xr[64 * j]; s += (v[j].x * v[j].x + v[j].y * v[j].y) + (v[j].z * v[j].z + v[j].w * v[j].w); }
            const float rstd = 1.0f / sqrtf(wave_sum(s) * (1.f / DM) + EPS);
            f32x4* o = (f32x4*)(p.out + (size_t)row * DM) + lane;
#pragma unroll
            for (int j = 0; j < 8; ++j) o[64 * j] = v[j] * rstd * ((const f32x4*)p.in[24])[lane + 64 * j];
        }
    }
#undef MOD
#undef GRID_BAR
}

extern "C" void kernel_launch(void* const* d_in, const int* in_sizes, int n_in, void* d_out, int out_size, void* d_ws, size_t ws_size, hipStream_t stream) {
    static int grid = 0;
    if (grid == 0) {
        if (n_in != 25 || ws_size < WS_END) { fprintf(stderr, "kernel_launch: n_in %d ws %zu (need 25, >= %zu)\n", n_in, ws_size, (size_t)WS_END); }
        int dev = 0, cus = 0, per_cu = 0;
        hipGetDevice(&dev);
        hipDeviceGetAttribute(&cus, hipDeviceAttributeMultiprocessorCount, dev);
        hipFuncSetAttribute((const void*)fwd_mega, hipFuncAttributeMaxDynamicSharedMemorySize, LDS_BYTES);
        hipOccupancyMaxActiveBlocksPerMultiprocessor(&per_cu, (const void*)fwd_mega, 512, LDS_BYTES);
        (void)hipGetLastError();
        if (per_cu < 1) { fprintf(stderr, "kernel_launch: occupancy query says %d blocks per CU\n", per_cu); per_cu = 1; }
        grid = cus;
    }
    (void)hipMemsetAsync(d_ws, 0, WS_CTL_BYTES, stream);
    Params p{};
    for (int i = 0; i < 25; ++i) p.in[i] = (const float*)d_in[i];
    p.out = (float*)d_out; p.ws = (unsigned char*)d_ws;
    void* args[] = {&p};
    hipError_t e = hipLaunchCooperativeKernel((const void*)fwd_mega, dim3(grid), dim3(512), args, LDS_BYTES, stream);
    if (e != hipSuccess) fprintf(stderr, "cooperative launch failed: %s (grid %d)\n", hipGetErrorString(e), grid);
}
```
